# Optimizing an MI355X kernel written in HIP

```python
import math
import jax, jax.numpy as jnp
from jax import lax
import numpy as np

D_MODEL = 1024
BATCH = 16
SEQ = 4096
DEPTH = 1

HEAD_DIM = 64
NSA_HEADS = 8
NSA_KV_HEADS = 2
NSA_GROUP = NSA_HEADS // NSA_KV_HEADS
SB_HEADS = 8
CMP_BLOCK = 32
CMP_STRIDE = 16
CMP_HIDDEN = HEAD_DIM
SEL_BLOCK = 64
SEL_TOPK = 16
WINDOW = 512
NSA_QBLOCK = 64
SB_QBLOCK = 128
N_BUCKETS = 32
MAX_DISTANCE = 128
D_FF = 4 * D_MODEL
EPS = 1e-6
FORCED_BONUS = 1e4
NEG_BLOCK = -1e9
NEG_LOGIT = -1e30

Q_A_W = NSA_HEADS * HEAD_DIM
KV_A_W = NSA_KV_HEADS * HEAD_DIM
GATE_A_W = NSA_HEADS * 3
SB_W = SB_HEADS * HEAD_DIM
IN_SPLITS = (Q_A_W, KV_A_W, KV_A_W, KV_A_W, KV_A_W, KV_A_W, KV_A_W, GATE_A_W, SB_W, SB_W, SB_W, D_MODEL, D_MODEL)
IN_WIDTH = Q_A_W + 6 * KV_A_W + GATE_A_W + 3 * SB_W + 2 * D_MODEL

kernel_name = 'hybrid_nsa_stickbreaking_adaln_block'


def rms_norm(x, g):
    x32 = x.astype(jnp.float32)
    y = x32 * lax.rsqrt(jnp.mean(x32 * x32, axis=-1, keepdims=True) + EPS)
    return (y * g.astype(jnp.float32)).astype(x.dtype)


def rel_bucket(dist):
    n = jnp.maximum(dist, 0)
    max_exact = N_BUCKETS // 2
    nf = jnp.maximum(n, 1).astype(jnp.float32)
    large = max_exact + (jnp.log(nf / max_exact) / math.log(MAX_DISTANCE / max_exact) * (N_BUCKETS - max_exact)).astype(jnp.int32)
    large = jnp.minimum(large, N_BUCKETS - 1)
    return jnp.where(n < max_exact, n, large)


def masked_softmax(logits, mask):
    masked = jnp.where(mask, logits, NEG_LOGIT)
    m = jnp.max(masked, axis=-1, keepdims=True)
    e = jnp.where(mask, jnp.exp(masked - m), 0.0)
    return e / jnp.maximum(jnp.sum(e, axis=-1, keepdims=True), 1e-30)


def compress_blocks(src, pos, w1, w2):
    B, S = src.shape[0], src.shape[1]
    nc = (S - CMP_BLOCK) // CMP_STRIDE + 1
    idx = jnp.arange(nc)[:, None] * CMP_STRIDE + jnp.arange(CMP_BLOCK)[None, :]
    blk = src[:, idx] + pos[None, None, :, None, :]
    blk = blk.transpose(0, 1, 3, 2, 4).reshape(B, nc, NSA_KV_HEADS, CMP_BLOCK * HEAD_DIM)
    return jax.nn.silu(blk @ w1) @ w2


def cmp_to_sel_overlap(nc, nsel):
    c_start = jnp.arange(nc) * CMP_STRIDE
    s_start = jnp.arange(nsel) * SEL_BLOCK
    ov = jnp.minimum(c_start[:, None] + CMP_BLOCK, s_start[None, :] + SEL_BLOCK) - jnp.maximum(c_start[:, None], s_start[None, :])
    return jnp.clip(ov, 0, CMP_BLOCK).astype(jnp.float32) / CMP_BLOCK


def nsa_attention(q, k_cmp, v_cmp, k_slc, v_slc, k_win, v_win, gates, rel_bias):
    B, S = q.shape[0], q.shape[1]
    nc = k_cmp.shape[1]
    nsel = S // SEL_BLOCK
    n_top = min(SEL_TOPK, nsel)
    scale = HEAD_DIM ** -0.5
    cmp_last = jnp.arange(nc) * CMP_STRIDE + CMP_BLOCK - 1
    overlap = cmp_to_sel_overlap(nc, nsel)
    tbl = rel_bias.astype(jnp.float32)
    tbl_g = tbl.reshape(N_BUCKETS, NSA_KV_HEADS, NSA_GROUP)
    ksel = k_slc.reshape(B, nsel, SEL_BLOCK, NSA_KV_HEADS, HEAD_DIM).transpose(0, 3, 1, 2, 4)
    vsel = v_slc.reshape(B, nsel, SEL_BLOCK, NSA_KV_HEADS, HEAD_DIM).transpose(0, 3, 1, 2, 4)
    kw_pad = jnp.pad(k_win, ((0, 0), (WINDOW, 0), (0, 0), (0, 0)))
    vw_pad = jnp.pad(v_win, ((0, 0), (WINDOW, 0), (0, 0), (0, 0)))
    bidx = jnp.arange(B)[:, None, None, None]
    hidx = jnp.arange(NSA_KV_HEADS)[None, :, None, None]
    blk = jnp.arange(nsel)
    tok_in_blk = jnp.arange(SEL_BLOCK)
    win_off = jnp.arange(WINDOW + NSA_QBLOCK)

    def head_bias(dist):
        b = tbl[rel_bucket(dist)]
        return jnp.moveaxis(b, -1, 0).reshape(NSA_KV_HEADS, NSA_GROUP, dist.shape[0], dist.shape[1])

    def block(i):
        start = i * NSA_QBLOCK
        t = start + jnp.arange(NSA_QBLOCK)
        qb = lax.dynamic_slice_in_dim(q, start, NSA_QBLOCK, axis=1)
        gb = lax.dynamic_slice_in_dim(gates, start, NSA_QBLOCK, axis=1)
        dist_c = t[:, None] - cmp_last[None, :]
        s_c = jnp.einsum('bqhgd,bchd->bhgqc', qb, k_cmp).astype(jnp.float32) * scale + head_bias(dist_c)
        p_c = masked_softmax(s_c, dist_c >= 0)
        o_c = jnp.einsum('bhgqc,bchd->bqhgd', p_c.astype(v_cmp.dtype), v_cmp)
        imp = jnp.einsum('bhgqc,cn->bhqn', p_c, overlap)
        cur = (t // SEL_BLOCK)[:, None]
        forced = (blk == 0) | (blk == cur) | (blk == cur - 1)
        imp = jnp.where(blk > cur, NEG_BLOCK, imp + jnp.where(forced, FORCED_BONUS, 0.0))
        _, top = lax.top_k(imp, n_top)
        kg = ksel[bidx, hidx, top]
        vg = vsel[bidx, hidx, top]
        tok = top[..., None] * SEL_BLOCK + tok_in_blk
        dist_s = t[:, None, None] - tok
        bias_s = jnp.moveaxis(tbl_g[rel_bucket(dist_s), hidx[..., None]], -1, 2)
        s_s = jnp.einsum('bqhgd,bhqnkd->bhgqnk', qb, kg).astype(jnp.float32) * scale + bias_s
        shp = s_s.shape
        m_s = (dist_s >= 0)[:, :, None].reshape(B, NSA_KV_HEADS, 1, NSA_QBLOCK, -1)
        p_s = masked_softmax(s_s.reshape(shp[0], shp[1], shp[2], shp[3], -1), m_s).reshape(shp)
        o_s = jnp.einsum('bhgqnk,bhqnkd->bqhgd', p_s.astype(vg.dtype), vg)
        kwb = lax.dynamic_slice_in_dim(kw_pad, start, WINDOW + NSA_QBLOCK, axis=1)
        vwb = lax.dynamic_slice_in_dim(vw_pad, start, WINDOW + NSA_QBLOCK, axis=1)
        s_pos = start - WINDOW + win_off
        dist_w = t[:, None] - s_pos[None, :]
        m_w = (dist_w >= 0) & (dist_w < WINDOW) & (s_pos >= 0)[None, :]
        s_w = jnp.einsum('bqhgd,bkhd->bhgqk', qb, kwb).astype(jnp.float32) * scale + head_bias(dist_w)
        p_w = masked_softmax(s_w, m_w)
        o_w = jnp.einsum('bhgqk,bkhd->bqhgd', p_w.astype(vwb.dtype), vwb)
        return gb[..., 0:1] * o_c + gb[..., 1:2] * o_s + gb[..., 2:3] * o_w

    out = lax.map(block, jnp.arange(S // NSA_QBLOCK))
    return jnp.swapaxes(out, 0, 1).reshape(B, S, NSA_HEADS * HEAD_DIM)


def stick_breaking_attention(q, k, v):
    B, S = q.shape[0], q.shape[1]
    scale = HEAD_DIM ** -0.5
    key_pos = jnp.arange(S)

    def block(i):
        start = i * SB_QBLOCK
        t = start + jnp.arange(SB_QBLOCK)
        qb = lax.dynamic_slice_in_dim(q, start, SB_QBLOCK, axis=1)
        z = jnp.einsum('bqhd,bshd->bhqs', qb, k).astype(jnp.float32) * scale
        mask = key_pos[None, :] < t[:, None]
        log_keep = jnp.where(mask, jax.nn.log_sigmoid(-z), 0.0)
        suffix = lax.cumsum(log_keep, axis=3, reverse=True) - log_keep
        a = jnp.where(mask, jnp.exp(jax.nn.log_sigmoid(z) + suffix), 0.0)
        return jnp.einsum('bhqs,bshd->bqhd', a.astype(v.dtype), v)

    out = lax.map(block, jnp.arange(S // SB_QBLOCK))
    return jnp.swapaxes(out, 0, 1).reshape(B, S, SB_HEADS * HEAD_DIM)


def setup_inputs(seed: int = 0) -> dict:
    key = jax.random.key(seed)
    ks = jax.random.split(key, 20)
    f32 = jnp.float32
    nrm = lambda k, shape, s: jax.random.normal(k, shape, f32) * s
    gain = lambda k, shape: 1.0 + 0.02 * jax.random.normal(k, shape, f32)
    return {
        'x': nrm(ks[0], (BATCH, SEQ, D_MODEL), 1.0),
        'c': nrm(ks[1], (BATCH, D_MODEL), 1.0),
        'rel_bias': nrm(ks[2], (N_BUCKETS, NSA_HEADS), 0.5),
        'ada_w': nrm(ks[3], (DEPTH, D_MODEL, 6 * D_MODEL), 0.5 * D_MODEL ** -0.5),
        'ada_b': nrm(ks[4], (DEPTH, 6 * D_MODEL), 0.02),
        'norm1_g': gain(ks[5], (DEPTH, D_MODEL)),
        'norm2_g': gain(ks[6], (DEPTH, D_MODEL)),
        'w_in': nrm(ks[7], (DEPTH, D_MODEL, IN_WIDTH), D_MODEL ** -0.5),
        'cmp_pos': nrm(ks[8], (DEPTH, CMP_BLOCK, HEAD_DIM), 0.5),
        'cmp_k_w1': nrm(ks[9], (DEPTH, CMP_BLOCK * HEAD_DIM, CMP_HIDDEN), (CMP_BLOCK * HEAD_DIM) ** -0.5),
        'cmp_k_w2': nrm(ks[10], (DEPTH, CMP_HIDDEN, HEAD_DIM), CMP_HIDDEN ** -0.5),
        'cmp_v_w1': nrm(ks[11], (DEPTH, CMP_BLOCK * HEAD_DIM, CMP_HIDDEN), (CMP_BLOCK * HEAD_DIM) ** -0.5),
        'cmp_v_w2': nrm(ks[12], (DEPTH, CMP_HIDDEN, HEAD_DIM), CMP_HIDDEN ** -0.5),
        'q_norm_g': gain(ks[13], (DEPTH, HEAD_DIM)),
        'k_norm_g': gain(ks[14], (DEPTH, 3, HEAD_DIM)),
        'w_up_nsa': nrm(ks[15], (DEPTH, Q_A_W, D_MODEL), Q_A_W ** -0.5),
        'w_up_sb': nrm(ks[16], (DEPTH, SB_W, D_MODEL), SB_W ** -0.5),
        'w_out': nrm(ks[17], (DEPTH, D_MODEL, D_MODEL), D_MODEL ** -0.5),
        'mlp_w1': nrm(ks[18], (DEPTH, D_MODEL, D_FF), D_MODEL ** -0.5),
        'mlp_w2': nrm(ks[19], (DEPTH, D_FF, D_MODEL), D_FF ** -0.5),
    }


def reference(x, c, rel_bias, ada_w, ada_b, norm1_g, norm2_g, w_in, cmp_pos, cmp_k_w1, cmp_k_w2, cmp_v_w1, cmp_v_w2, q_norm_g, k_norm_g, w_up_nsa, w_up_sb, w_out, mlp_w1, mlp_w2):
    B, S, _ = x.shape
    split_at = np.cumsum(IN_SPLITS)[:-1].tolist()
    kv_shape = (B, S, NSA_KV_HEADS, HEAD_DIM)
    sb_shape = (B, S, SB_HEADS, HEAD_DIM)
    h = x
    for layer in range(DEPTH):
        mod = jax.nn.silu(c) @ ada_w[layer] + ada_b[layer]
        shift1, scale1, gate1, shift2, scale2, gate2 = [m[:, None, :] for m in jnp.split(mod, 6, axis=-1)]
        u = rms_norm(h, norm1_g[layer]) * (1 + scale1) + shift1
        z = u @ w_in[layer]
        q_a, kc, vc, ksl, vsl, kwn, vwn, g_a, q_b, k_b, v_b, m_a, m_b = jnp.split(z, split_at, axis=-1)
        q_a = rms_norm(q_a.reshape(B, S, NSA_HEADS, HEAD_DIM), q_norm_g[layer]).reshape(B, S, NSA_KV_HEADS, NSA_GROUP, HEAD_DIM)
        k_cmp = rms_norm(compress_blocks(kc.reshape(kv_shape), cmp_pos[layer], cmp_k_w1[layer], cmp_k_w2[layer]), k_norm_g[layer, 0])
        v_cmp = compress_blocks(vc.reshape(kv_shape), cmp_pos[layer], cmp_v_w1[layer], cmp_v_w2[layer])
        k_slc = rms_norm(ksl.reshape(kv_shape), k_norm_g[layer, 1])
        k_win = rms_norm(kwn.reshape(kv_shape), k_norm_g[layer, 2])
        g_nsa = jax.nn.sigmoid(g_a).reshape(B, S, NSA_KV_HEADS, NSA_GROUP, 3)
        y_a = nsa_attention(q_a, k_cmp, v_cmp, k_slc, vsl.reshape(kv_shape), k_win, vwn.reshape(kv_shape), g_nsa, rel_bias) @ w_up_nsa[layer]
        y_b = stick_breaking_attention(q_b.reshape(sb_shape), k_b.reshape(sb_shape), v_b.reshape(sb_shape)) @ w_up_sb[layer]
        mixed = (jax.nn.sigmoid(m_a) * y_a + jax.nn.sigmoid(m_b) * y_b) @ w_out[layer]
        h = h + gate1 * mixed
        u2 = rms_norm(h, norm2_g[layer]) * (1 + scale2) + shift2
        ff = jnp.square(jax.nn.relu(u2 @ mlp_w1[layer])) @ mlp_w2[layer]
        h = h + gate2 * ff
    return h
```

```cpp
#include <hip/hip_runtime.h>
#include <hip/hip_cooperative_groups.h>
#include <cstdio>
#include <cstdint>
namespace cg = cooperative_groups;

constexpr int NB = 16, S = 4096, DM = 1024, M = NB * S, FF = 4096;
constexpr int ZW = 4864;
constexpr int ZQ = 0, ZKC = 512, ZVC = 640, ZKS = 768, ZVS = 896, ZKW = 1024, ZVW = 1152, ZQB = 1280, ZKB = 1792, ZVB = 2304, ZMA = 2816, ZMB = 3840;
constexpr int NIN = 5120;
constexpr size_t MiB = (size_t)1 << 20;
constexpr size_t WS_WIN = 1 * MiB, WS_WUPA = 11 * MiB, WS_WUPB = 12 * MiB, WS_WOUT = 13 * MiB, WS_W1 = 15 * MiB, WS_W2 = 23 * MiB;
constexpr size_t WS_MOD = 31 * MiB, WS_PW1 = 31 * MiB + 400 * 1024, WS_CW1K = 31 * MiB + 512 * 1024, WS_CW1V = WS_CW1K + 256 * 1024;
constexpr size_t WS_KC = 32 * MiB, WS_VCT = 33 * MiB, WS_VST = 34 * MiB, WS_VWT = 50 * MiB, WS_VBT = 66 * MiB;
constexpr size_t WS_XN = 130 * MiB, WS_ATTA = 258 * MiB, WS_ATTB = 322 * MiB, WS_Z = 386 * MiB, WS_G = 994 * MiB, WS_ROWSS = 1000 * MiB, WS_SW = 1001 * MiB, WS_END = 1002 * MiB;
constexpr float LOG2E = 1.4426950408889634f, LN2 = 0.6931471805599453f;
#ifndef REP_NSA
#define REP_NSA 1
#endif
#ifndef REP_SB
#define REP_SB 1
#endif
#define REP_P0 1
#define REP_P1 1
#define REP_P3 1
namespace pg8 {
#define PG8_LAS __attribute__((address_space(3)))
typedef unsigned short bf16_t;
typedef short bf16x8 __attribute__((ext_vector_type(8)));
typedef float f32x4 __attribute__((ext_vector_type(4)));
typedef unsigned u32x4 __attribute__((ext_vector_type(4)));
constexpr int BM = 256, BK = 64, HALF = 128, HTB = HALF * BK * 2  , STAGE_BYTES = 8 * HTB, NXCD = 8, WGM = 8;

__host__ __device__ __forceinline__ int lds_byte(int r, int c) { const int st = (r >> 4) * 2 + (c >> 5), rr = r & 15, cc = c & 31, ob = rr * 64 + cc * 2; return st * 1024 + (ob ^ (((ob >> 9) & 1) << 5)); }
__host__ __device__ __forceinline__ void stage_rc(int b, int& R, int& C) { const int st = b / 1024, sb = b % 1024, swz = sb ^ (((sb >> 9) & 1) << 5); R = (st >> 1) * 16 + swz / 64; C = (st & 1) * 32 + (swz % 64) / 2; }
__host__ __device__ __forceinline__ int perm32(int rho) { const int n = rho >> 4, i = rho & 15; return 8 * (i >> 2) + 4 * n + (i & 3); }

struct Unit { int pm, pn; };
struct Gemm { const bf16_t* A; const bf16_t* Bt; int M, N, K; };

struct StaticOrder {
    int nM, nN, nwg, G, c;
    __host__ __device__ void init(int M, int N, int G_, int c_) { nM = M / BM; nN = N / BM; nwg = nM * nN; G = G_; c = c_; }
    __host__ __device__ bool next(int i, Unit& u) const {
        const long L = (long)i * G + c; if (L >= nwg) return false;
        int wgid = (int)L; { const int q = nwg / NXCD, r = nwg % NXCD, xcd = wgid % NXCD, off = wgid / NXCD; wgid = (xcd < r ? xcd * (q + 1) : r * (q + 1) + (xcd - r) * q) + off; }
        const int nig = WGM * nN, gid = wgid / nig, fm = gid * WGM, gsz = (nM - fm) < WGM ? (nM - fm) : WGM;
        u.pm = fm + ((wgid % nig) % gsz); u.pn = (wgid % nig) / gsz; return true;
    }
    __device__ __forceinline__ void a_ready(const Unit&) const {}
    __device__ __forceinline__ void done(const Unit&) const {}
};

__device__ __forceinline__ unsigned cvt_pk_bf16(float lo, float hi) { unsigned r; asm volatile("v_cvt_pk_bf16_f32 %0, %1, %2" : "=v"(r) : "v"(lo), "v"(hi)); return r; }
__device__ __forceinline__ float sigm(float x) { return __builtin_amdgcn_rcpf(1.0f + __builtin_amdgcn_exp2f(-1.4426950408889634f * x)); }
__device__ __forceinline__ float bflo(unsigned u) { return __uint_as_float(u << 16); }
__device__ __forceinline__ float bfhi(unsigned u) { return __uint_as_float(u & 0xffff0000u); }
struct EpiZ {
    static constexpr bool PERM = true, AFTER_DRAIN = false, HAS_MID = false;
    bf16_t* Z; float* G;
    __device__ __forceinline__ void operator()(const f32x4 (&acc)[2][2][4][2], const Unit& u, int wr, int wc, int fr, int fq) const {
        const int row0 = u.pm * BM + wr * 64 + fr; const int colt = u.pn * BM + wc * 32 + 8 * fq;
        if (u.pn < 19) {
            const bool sg = u.pn >= 11;
#pragma unroll
            for (int ai = 0; ai < 2; ++ai)
#pragma unroll
                for (int m = 0; m < 4; ++m) { bf16_t* rowp = Z + (size_t)(row0 + ai * HALF + m * 16) * ZW + colt;
#pragma unroll
                    for (int bj = 0; bj < 2; ++bj) { f32x4 v0 = acc[ai][bj][m][0], v1 = acc[ai][bj][m][1];
                        if (sg) { v0 = (f32x4){sigm(v0[0]), sigm(v0[1]), sigm(v0[2]), sigm(v0[3])}; v1 = (f32x4){sigm(v1[0]), sigm(v1[1]), sigm(v1[2]), sigm(v1[3])}; }
                        u32x4 w; w.x = cvt_pk_bf16(v0[0], v0[1]); w.y = cvt_pk_bf16(v0[2], v0[3]); w.z = cvt_pk_bf16(v1[0], v1[1]); w.w = cvt_pk_bf16(v1[2], v1[3]);
                        *(u32x4*)(rowp + bj * HALF) = w; } }
        } else if (wc == 0 && fq < 3) {
#pragma unroll
            for (int ai = 0; ai < 2; ++ai)
#pragma unroll
                for (int m = 0; m < 4; ++m) { float* gp = G + (size_t)(row0 + ai * HALF + m * 16) * 24 + 8 * fq; const f32x4 v0 = acc[ai][0][m][0], v1 = acc[ai][0][m][1];
                    *(f32x4*)gp = (f32x4){sigm(v0[0]), sigm(v0[1]), sigm(v0[2]), sigm(v0[3])}; *(f32x4*)(gp + 4) = (f32x4){sigm(v1[0]), sigm(v1[1]), sigm(v1[2]), sigm(v1[3])}; }
        }
    }
};
__device__ __forceinline__ float gclamp(float g) { return g > 1.0e-20f ? g : 1.0e-20f; }
struct EpiUpF {
    static constexpr bool PERM = true, AFTER_DRAIN = false, HAS_MID = true;
    bf16_t* Y; const bf16_t* Zg;
    __device__ __forceinline__ void mid(f32x4 (&acc)[2][2][4][2], const Unit& u, int wr, int wc, int fr, int fq) const {
        int row0 = u.pm * BM + wr * 64 + fr; int colt = u.pn * BM + wc * 32 + 8 * fq;
        asm volatile("" : "+v"(row0), "+v"(colt));
#pragma unroll
        for (int ai = 0; ai < 2; ++ai)
#pragma unroll
            for (int m = 0; m < 4; ++m) { const size_t row = (size_t)(row0 + ai * HALF + m * 16);
#pragma unroll
                for (int bj = 0; bj < 2; ++bj) { const int col = colt + bj * HALF;
                    const u32x4 ga = *(const u32x4*)(Zg + row * ZW + ZMA + col), gb = *(const u32x4*)(Zg + row * ZW + ZMB + col);
                    f32x4& a0 = acc[ai][bj][m][0]; f32x4& a1 = acc[ai][bj][m][1];
                    a0[0] *= bflo(ga.x) * __builtin_amdgcn_rcpf(gclamp(bflo(gb.x))); a0[1] *= bfhi(ga.x) * __builtin_amdgcn_rcpf(gclamp(bfhi(gb.x)));
                    a0[2] *= bflo(ga.y) * __builtin_amdgcn_rcpf(gclamp(bflo(gb.y))); a0[3] *= bfhi(ga.y) * __builtin_amdgcn_rcpf(gclamp(bfhi(gb.y)));
                    a1[0] *= bflo(ga.z) * __builtin_amdgcn_rcpf(gclamp(bflo(gb.z))); a1[1] *= bfhi(ga.z) * __builtin_amdgcn_rcpf(gclamp(bfhi(gb.z)));
                    a1[2] *= bflo(ga.w) * __builtin_amdgcn_rcpf(gclamp(bflo(gb.w))); a1[3] *= bfhi(ga.w) * __builtin_amdgcn_rcpf(gclamp(bfhi(gb.w))); }
                if (m & 1) asm volatile("" ::: "memory"); }
    }
    __device__ __forceinline__ void operator()(const f32x4 (&acc)[2][2][4][2], const Unit& u, int wr, int wc, int fr, int fq) const {
        const int row0 = u.pm * BM + wr * 64 + fr; const int colt = u.pn * BM + wc * 32 + 8 * fq;
#pragma unroll
        for (int ai = 0; ai < 2; ++ai)
#pragma unroll
            for (int m = 0; m < 4; ++m) { const size_t row = (size_t)(row0 + ai * HALF + m * 16);
#pragma unroll
                for (int bj = 0; bj < 2; ++bj) { const int col = colt + bj * HALF; const u32x4 gt = *(const u32x4*)(Zg + row * ZW + ZMB + col);
                    const f32x4 a0 = acc[ai][bj][m][0], a1 = acc[ai][bj][m][1];
                    u32x4 w; w.x = cvt_pk_bf16(a0[0] * gclamp(bflo(gt.x)), a0[1] * gclamp(bfhi(gt.x))); w.y = cvt_pk_bf16(a0[2] * gclamp(bflo(gt.y)), a0[3] * gclamp(bfhi(gt.y)));
                    w.z = cvt_pk_bf16(a1[0] * gclamp(bflo(gt.z)), a1[1] * gclamp(bfhi(gt.z))); w.w = cvt_pk_bf16(a1[2] * gclamp(bflo(gt.w)), a1[3] * gclamp(bfhi(gt.w)));
                    *(u32x4*)(Y + row * DM + col) = w; }
                if (m & 1) asm volatile("" ::: "memory"); }
    }
};
struct EpiRes {
    static constexpr bool PERM = true, AFTER_DRAIN = false, HAS_MID = false;
    const float* base; float* out; const float* gate;
    __device__ __forceinline__ void operator()(const f32x4 (&acc)[2][2][4][2], const Unit& u, int wr, int wc, int fr, int fq) const {
        const int row0 = u.pm * BM + wr * 64 + fr; const int colt = u.pn * BM + wc * 32 + 8 * fq; const int b = (u.pm * BM) >> 12;
        f32x4 bv[2][4];
#define ER_LOAD(buf, k_) do { const int bj_ = (k_) >> 2, ai_ = ((k_) >> 1) & 1, n_ = (k_) & 1; _Pragma("unroll") for (int m = 0; m < 4; ++m) bv[buf][m] = *(const f32x4*)(base + (size_t)(row0 + ai_ * HALF + m * 16) * DM + colt + bj_ * HALF + 4 * n_); } while (0)
        ER_LOAD(0, 0);
#pragma unroll
        for (int k = 0; k < 8; ++k) { const int bj = k >> 2, ai = (k >> 1) & 1, n = k & 1, cb = k & 1;
            if (k + 1 < 8) ER_LOAD(cb ^ 1, k + 1);
            const f32x4 g = *(const f32x4*)(gate + (size_t)b * 6144 + colt + bj * HALF + 4 * n);
            asm volatile("" ::: "memory");
#pragma unroll
            for (int m = 0; m < 4; ++m) *(f32x4*)(out + (size_t)(row0 + ai * HALF + m * 16) * DM + colt + bj * HALF + 4 * n) = bv[cb][m] + g * acc[ai][bj][m][n];
            asm volatile("" ::: "memory"); }
#undef ER_LOAD
    }
};
struct EpiRelu2 {
    static constexpr bool PERM = true, AFTER_DRAIN = false, HAS_MID = false;
    bf16_t* H;
    __device__ __forceinline__ void operator()(const f32x4 (&acc)[2][2][4][2], const Unit& u, int wr, int wc, int fr, int fq) const {
        const int row0 = u.pm * BM + wr * 64 + fr; const int colt = u.pn * BM + wc * 32 + 8 * fq;
#pragma unroll
        for (int ai = 0; ai < 2; ++ai)
#pragma unroll
            for (int m = 0; m < 4; ++m) { bf16_t* rowp = H + (size_t)(row0 + ai * HALF + m * 16) * FF + colt;
#pragma unroll
                for (int bj = 0; bj < 2; ++bj) { f32x4 v0 = acc[ai][bj][m][0], v1 = acc[ai][bj][m][1];
                    v0 = __builtin_elementwise_max(v0, (f32x4){0.f, 0.f, 0.f, 0.f}); v1 = __builtin_elementwise_max(v1, (f32x4){0.f, 0.f, 0.f, 0.f}); v0 = v0 * v0; v1 = v1 * v1;
                    u32x4 w; w.x = cvt_pk_bf16(v0[0], v0[1]); w.y = cvt_pk_bf16(v0[2], v0[3]); w.z = cvt_pk_bf16(v1[0], v1[1]); w.w = cvt_pk_bf16(v1[2], v1[3]);
                    *(u32x4*)(rowp + bj * HALF) = w; } }
    }
};
struct EpiRes2 {
    static constexpr bool PERM = true, AFTER_DRAIN = false, HAS_MID = false;
    const float* base; float* out; const float* gate; const float* g2; const float* scale2; bf16_t* XN2; float* rowss;
    __device__ __forceinline__ void operator()(const f32x4 (&acc)[2][2][4][2], const Unit& u, int wr, int wc, int fr, int fq) const {
        const int row0 = u.pm * BM + wr * 64 + fr; const int colt = u.pn * BM + wc * 32 + 8 * fq; const int b = (u.pm * BM) >> 12;
        float ss[8];
#pragma unroll
        for (int r = 0; r < 8; ++r) ss[r] = 0.f;
#pragma unroll
        for (int bj = 0; bj < 2; ++bj) { const int c = colt + bj * HALF;
            const f32x4 gt0 = *(const f32x4*)(gate + (size_t)b * 6144 + c), gt1 = *(const f32x4*)(gate + (size_t)b * 6144 + c + 4);
            const f32x4 gm0 = *(const f32x4*)(g2 + c) * (*(const f32x4*)(scale2 + (size_t)b * 6144 + c) + 1.0f), gm1 = *(const f32x4*)(g2 + c + 4) * (*(const f32x4*)(scale2 + (size_t)b * 6144 + c + 4) + 1.0f);
#pragma unroll
            for (int ai = 0; ai < 2; ++ai) {
                f32x4 bv[4][2];
#pragma unroll
                for (int m = 0; m < 4; ++m) { const size_t off = (size_t)(row0 + ai * HALF + m * 16) * DM + c; bv[m][0] = *(const f32x4*)(base + off); bv[m][1] = *(const f32x4*)(base + off + 4); }
                asm volatile("" ::: "memory");
#pragma unroll
                for (int m = 0; m < 4; ++m) { const size_t off = (size_t)(row0 + ai * HALF + m * 16) * DM + c;
                    const f32x4 h0 = bv[m][0] + gt0 * acc[ai][bj][m][0], h1 = bv[m][1] + gt1 * acc[ai][bj][m][1];
                    *(f32x4*)(out + off) = h0; *(f32x4*)(out + off + 4) = h1;
                    ss[ai * 4 + m] += (h0[0] * h0[0] + h0[1] * h0[1]) + (h0[2] * h0[2] + h0[3] * h0[3]) + (h1[0] * h1[0] + h1[1] * h1[1]) + (h1[2] * h1[2] + h1[3] * h1[3]);
                    const f32x4 v0 = h0 * gm0, v1 = h1 * gm1;
                    u32x4 w; w.x = cvt_pk_bf16(v0[0], v0[1]); w.y = cvt_pk_bf16(v0[2], v0[3]); w.z = cvt_pk_bf16(v1[0], v1[1]); w.w = cvt_pk_bf16(v1[2], v1[3]);
                    *(u32x4*)(XN2 + off) = w; }
                asm volatile("" ::: "memory"); } }
#pragma unroll
        for (int r = 0; r < 8; ++r) { float s = ss[r]; s += __shfl_xor(s, 16); s += __shfl_xor(s, 32);
            if (fq == 0) atomicAdd(rowss + row0 + (r >> 2) * HALF + (r & 3) * 16, s); }
    }
};
struct EpiRelu2N {
    static constexpr bool PERM = true, AFTER_DRAIN = false, HAS_MID = false;
    bf16_t* H; const float* rowss; const float* sw;
    __device__ __forceinline__ void operator()(const f32x4 (&acc)[2][2][4][2], const Unit& u, int wr, int wc, int fr, int fq) const {
        const int row0 = u.pm * BM + wr * 64 + fr; const int colt = u.pn * BM + wc * 32 + 8 * fq; const int b = (u.pm * BM) >> 12;
        float rstd[8];
#pragma unroll
        for (int r = 0; r < 8; ++r) rstd[r] = __builtin_amdgcn_rsqf(rowss[row0 + (r >> 2) * HALF + (r & 3) * 16] * (1.0f / DM) + 1e-6f);
#pragma unroll
        for (int bj = 0; bj < 2; ++bj) { const f32x4 sv0 = *(const f32x4*)(sw + (size_t)b * FF + colt + bj * HALF), sv1 = *(const f32x4*)(sw + (size_t)b * FF + colt + bj * HALF + 4);
#pragma unroll
            for (int ai = 0; ai < 2; ++ai)
#pragma unroll
                for (int m = 0; m < 4; ++m) { bf16_t* rowp = H + (size_t)(row0 + ai * HALF + m * 16) * FF + colt + bj * HALF;
                    f32x4 v0 = acc[ai][bj][m][0] * rstd[ai * 4 + m] + sv0, v1 = acc[ai][bj][m][1] * rstd[ai * 4 + m] + sv1;
                    v0 = __builtin_elementwise_max(v0, (f32x4){0.f, 0.f, 0.f, 0.f}); v1 = __builtin_elementwise_max(v1, (f32x4){0.f, 0.f, 0.f, 0.f}); v0 = v0 * v0; v1 = v1 * v1;
                    u32x4 w; w.x = cvt_pk_bf16(v0[0], v0[1]); w.y = cvt_pk_bf16(v0[2], v0[3]); w.z = cvt_pk_bf16(v1[0], v1[1]); w.w = cvt_pk_bf16(v1[2], v1[3]);
                    *(u32x4*)rowp = w; } }
    }
};
template <class Epi, class Sched, bool ALIGN_EPI = false, bool SP2 = false>
__device__ __forceinline__ void gemm_phase(PG8_LAS unsigned char* lds, const Gemm g, const Sched& S, const Epi& E) {
    int tid_ = threadIdx.x; asm volatile("" : "+v"(tid_));
    const int tid = tid_, wid = __builtin_amdgcn_readfirstlane(tid >> 6), lane = tid & 63, wr = wid >> 2, wc = wid & 3, fr = lane & 15, fq = lane >> 4;
    const int K = g.K, nt = K / BK;
    unsigned voffA[2], voffB[2];
#pragma unroll
    for (int i = 0; i < 2; ++i) { int R, C; stage_rc(tid * 16 + i * 8192, R, C); const int Rb = Epi::PERM ? ((R & ~31) + perm32(R & 31)) : R;
        voffA[i] = (unsigned)(R * K + C) * 2u; voffB[i] = (unsigned)(Rb * K + C) * 2u; }
    const size_t kstep = (size_t)(BK * 2);
    const size_t hstep = (size_t)HALF * K * 2;
    const size_t tstep = 2 * hstep;
    const unsigned ldsw = (unsigned)wid * 1024u;
    const int aoff = lds_byte(wr * 64 + fr, fq * 8), boff = lds_byte(wc * 32 + fr, fq * 8);
#define PG8_SA(b, h) (((b) * 2 + (h)) * HTB)
#define PG8_SB(b, h) ((4 + (b) * 2 + (h)) * HTB)
#define PG8_STAGE(bufoff, gbase, voff) do { _Pragma("unroll") for (int _i = 0; _i < 2; ++_i) \
        __builtin_amdgcn_global_load_lds((const unsigned*)((const char*)(gbase) + (voff)[_i]), (PG8_LAS unsigned*)(lds + (bufoff) + ldsw + _i * 8192), 16, 0, 0); } while (0)
#define PG8_LDA(dst, b, h) do { _Pragma("unroll") for (int m = 0; m < 4; ++m) _Pragma("unroll") for (int k = 0; k < 2; ++k) dst[m][k] = *(const PG8_LAS bf16x8*)(lds + PG8_SA(b, h) + aoff + m * 2048 + k * 1024); } while (0)
#define PG8_LDB(dst, b, h) do { _Pragma("unroll") for (int n = 0; n < 2; ++n) _Pragma("unroll") for (int k = 0; k < 2; ++k) dst[n][k] = *(const PG8_LAS bf16x8*)(lds + PG8_SB(b, h) + boff + n * 2048 + k * 1024); } while (0)
#define PG8_MMA(ai, bj, At, Bt) do { __builtin_amdgcn_s_setprio(1); _Pragma("unroll") for (int m = 0; m < 4; ++m) _Pragma("unroll") for (int n = 0; n < 2; ++n) _Pragma("unroll") for (int k = 0; k < 2; ++k) \
        acc[ai][bj][m][n] = __builtin_amdgcn_mfma_f32_16x16x32_bf16(Bt[n][k], At[m][k], acc[ai][bj][m][n], 0, 0, 0); __builtin_amdgcn_s_setprio(0); } while (0)
#define PG8_WAIT_V(n) asm volatile("s_waitcnt vmcnt(" #n ")" ::: "memory")
#define PG8_WAIT_L(n) asm volatile("s_waitcnt lgkmcnt(" #n ")" ::: "memory")
#define PG8_BAR __builtin_amdgcn_s_barrier()
#define PG8_SCHED __builtin_amdgcn_sched_barrier(0)
    Unit cur, nxt; int ui = 0;
    if (!S.next(0, cur)) return;
    f32x4 acc[2][2][4][2];
#pragma unroll
    for (int a = 0; a < 2; ++a)
#pragma unroll
        for (int b = 0; b < 2; ++b)
#pragma unroll
            for (int m = 0; m < 4; ++m)
#pragma unroll
                for (int n = 0; n < 2; ++n) acc[a][b][m][n] = (f32x4){0.f, 0.f, 0.f, 0.f};
    bf16x8 At[4][2], B0[2][2], B1[2][2];
    const char* cA = (const char*)g.A + (size_t)cur.pm * tstep; const char* cB = (const char*)g.Bt + (size_t)cur.pn * tstep;
    S.a_ready(cur);
    if constexpr (SP2) {
        PG8_STAGE(PG8_SB(0, 0), cB, voffB); PG8_STAGE(PG8_SB(0, 1), cB + hstep, voffB); PG8_STAGE(PG8_SA(0, 0), cA, voffA); PG8_STAGE(PG8_SA(0, 1), cA + hstep, voffA);
        if (wr == 1) PG8_BAR;
        PG8_WAIT_V(2); PG8_BAR;
        PG8_STAGE(PG8_SB(1, 0), cB + kstep, voffB); PG8_STAGE(PG8_SA(1, 0), cA + kstep, voffA); PG8_STAGE(PG8_SB(1, 1), cB + hstep + kstep, voffB);
        PG8_WAIT_V(6); PG8_BAR;
    } else {
        PG8_STAGE(PG8_SB(0, 0), cB, voffB); PG8_STAGE(PG8_SA(0, 0), cA, voffA); PG8_STAGE(PG8_SB(0, 1), cB + hstep, voffB); PG8_STAGE(PG8_SA(0, 1), cA + hstep, voffA);
        if (wr == 1) PG8_BAR;
        PG8_WAIT_V(4); PG8_BAR;
        PG8_STAGE(PG8_SB(1, 0), cB + kstep, voffB); PG8_STAGE(PG8_SA(1, 0), cA + kstep, voffA); PG8_STAGE(PG8_SB(1, 1), cB + hstep + kstep, voffB);
        PG8_WAIT_V(6); PG8_BAR;
    }
    for (;;) {
        const bool has_next = S.next(ui + 1, nxt);
        const char* nA = has_next ? (const char*)g.A + (size_t)nxt.pm * tstep : cA; const char* nB = has_next ? (const char*)g.Bt + (size_t)nxt.pn * tstep : cB;
        for (int t = 0; t < nt; t += 2) {
            if constexpr (Epi::HAS_MID) { if (t == nt / 2) E.mid(acc, cur, wr, wc, fr, fq); }
            const bool last = (t == nt - 2);
            const char* a1 = cA + (size_t)(t + 1) * kstep;
            const char* a2 = last ? nA : cA + (size_t)(t + 2) * kstep; const char* b2 = last ? nB : cB + (size_t)(t + 2) * kstep;
            const char* a3 = a2 + kstep; const char* b3 = b2 + kstep;
            if (last && has_next) S.a_ready(nxt);
            if constexpr (SP2) {
            PG8_LDB(B0, 0, 0); PG8_LDB(B1, 0, 1); PG8_SCHED; PG8_LDA(At, 0, 0); PG8_STAGE(PG8_SA(1, 1), a1 + hstep, voffA);
            PG8_WAIT_V(8); PG8_WAIT_L(0); PG8_BAR; PG8_MMA(0, 0, At, B0); PG8_MMA(0, 1, At, B1); PG8_BAR; PG8_SCHED;
            PG8_LDA(At, 0, 1); PG8_STAGE(PG8_SB(0, 0), b2, voffB); PG8_STAGE(PG8_SB(0, 1), b2 + hstep, voffB); PG8_STAGE(PG8_SA(0, 0), a2, voffA);
            PG8_WAIT_V(8); PG8_WAIT_L(0); PG8_BAR; PG8_MMA(1, 0, At, B0); PG8_MMA(1, 1, At, B1); PG8_BAR; PG8_SCHED;
            PG8_LDB(B0, 1, 0); PG8_LDB(B1, 1, 1); PG8_SCHED; PG8_LDA(At, 1, 0); PG8_STAGE(PG8_SA(0, 1), a2 + hstep, voffA);
            PG8_WAIT_V(8); PG8_WAIT_L(0); PG8_BAR; PG8_MMA(0, 0, At, B0); PG8_MMA(0, 1, At, B1); PG8_BAR; PG8_SCHED;
            PG8_LDA(At, 1, 1); PG8_STAGE(PG8_SB(1, 0), b3, voffB); PG8_STAGE(PG8_SB(1, 1), b3 + hstep, voffB); PG8_STAGE(PG8_SA(1, 0), a3, voffA);
            PG8_WAIT_V(8); PG8_WAIT_L(0); PG8_BAR; PG8_MMA(1, 0, At, B0); PG8_MMA(1, 1, At, B1); PG8_BAR; PG8_SCHED;
            } else {
            PG8_LDB(B0, 0, 0); PG8_SCHED; PG8_LDA(At, 0, 0); PG8_STAGE(PG8_SA(1, 1), a1 + hstep, voffA);
            PG8_WAIT_L(8); PG8_BAR; PG8_WAIT_L(0); PG8_MMA(0, 0, At, B0); PG8_BAR; PG8_SCHED;
            PG8_LDB(B1, 0, 1); PG8_STAGE(PG8_SB(0, 0), b2, voffB);
            PG8_BAR; PG8_WAIT_L(0); PG8_MMA(0, 1, At, B1); PG8_BAR;
            PG8_LDA(At, 0, 1); PG8_STAGE(PG8_SA(0, 0), a2, voffA);
            PG8_BAR; PG8_WAIT_L(0); PG8_MMA(1, 0, At, B0); PG8_BAR; PG8_SCHED;
            PG8_STAGE(PG8_SB(0, 1), b2 + hstep, voffB);
            PG8_WAIT_V(6); PG8_BAR; PG8_MMA(1, 1, At, B1); PG8_BAR;
            PG8_LDB(B0, 1, 0); PG8_SCHED; PG8_LDA(At, 1, 0); PG8_STAGE(PG8_SA(0, 1), a2 + hstep, voffA);
            PG8_WAIT_L(8); PG8_BAR; PG8_WAIT_L(0); PG8_MMA(0, 0, At, B0); PG8_BAR; PG8_SCHED;
            PG8_LDB(B1, 1, 1); PG8_STAGE(PG8_SB(1, 0), b3, voffB);
            PG8_BAR; PG8_WAIT_L(0); PG8_MMA(0, 1, At, B1); PG8_BAR;
            PG8_LDA(At, 1, 1); PG8_STAGE(PG8_SA(1, 0), a3, voffA);
            PG8_BAR; PG8_WAIT_L(0); PG8_MMA(1, 0, At, B0); PG8_BAR; PG8_SCHED;
            PG8_STAGE(PG8_SB(1, 1), b3 + hstep, voffB);
            PG8_WAIT_V(6); PG8_BAR; PG8_MMA(1, 1, At, B1); PG8_BAR;
            }
        }
        if constexpr (ALIGN_EPI) { if (wr == 0) PG8_BAR; }
        if constexpr (!Epi::AFTER_DRAIN) { E(acc, cur, wr, wc, fr, fq); S.done(cur); }
        if (!has_next) break;
#pragma unroll
        for (int a = 0; a < 2; ++a)
#pragma unroll
            for (int b = 0; b < 2; ++b)
#pragma unroll
                for (int m = 0; m < 4; ++m)
#pragma unroll
                    for (int n = 0; n < 2; ++n) acc[a][b][m][n] = (f32x4){0.f, 0.f, 0.f, 0.f};
        cur = nxt; cA = nA; cB = nB; ++ui;
        if constexpr (ALIGN_EPI) { if (wr == 1) PG8_BAR; }
    }
    PG8_WAIT_V(0);
    if constexpr (!ALIGN_EPI) { if (wr == 0) PG8_BAR; }
    PG8_BAR;
    if constexpr (Epi::AFTER_DRAIN) { E.fused(acc, cur, wr, wc, fr, fq, lds, wid, lane); S.done(cur); }
#undef PG8_SA
#undef PG8_SB
#undef PG8_STAGE
#undef PG8_LDA
#undef PG8_LDB
#undef PG8_MMA
#undef PG8_WAIT_V
#undef PG8_WAIT_L
#undef PG8_BAR
#undef PG8_SCHED
}
}

#define LAS __attribute__((address_space(3)))
typedef unsigned short bf16;
typedef unsigned v4u __attribute__((ext_vector_type(4)));
typedef unsigned v2u __attribute__((ext_vector_type(2)));
typedef float f32x4 __attribute__((ext_vector_type(4)));
typedef float f32x16 __attribute__((ext_vector_type(16)));
typedef short bf16x8 __attribute__((ext_vector_type(8)));
typedef float f32x2_t __attribute__((ext_vector_type(2)));
typedef __bf16 bf16x2_t __attribute__((ext_vector_type(2)));
#define LDS_WAIT() asm volatile("s_waitcnt lgkmcnt(0)" ::: "memory")
constexpr int LDS_BYTES = 147456;
constexpr int NWAVES = 8;

struct Params { const float* in[20]; float* out; unsigned char* ws; };

__device__ __forceinline__ unsigned pk2(float lo, float hi) { f32x2_t v = {lo, hi}; bf16x2_t b = __builtin_convertvector(v, bf16x2_t); return __builtin_bit_cast(unsigned, b); }
__device__ __forceinline__ float bflo(unsigned u) { return __uint_as_float(u << 16); }
__device__ __forceinline__ float bfhi(unsigned u) { return __uint_as_float(u & 0xffff0000u); }
__device__ __forceinline__ float ex2(float x) { return __builtin_amdgcn_exp2f(x); }
__device__ __forceinline__ float lg2(float x) { return __builtin_amdgcn_logf(x); }
__device__ __forceinline__ float rcp(float x) { return __builtin_amdgcn_rcpf(x); }
__device__ __forceinline__ float sigm(float x) { return rcp(1.0f + ex2(-LOG2E * x)); }
__device__ __forceinline__ float wave_sum(float v) {
#pragma unroll
    for (int o = 1; o < 64; o <<= 1) v += __shfl_xor(v, o);
    return v;
}

__device__ __forceinline__ void transpose_item(const float* W, int ldw, int K, int ncols, bf16* WT, int row_off, LAS float* scr, int item, int lane) {
    const int nblk = ncols / 32, kb = item / nblk, nb = item % nblk, k0 = 64 * kb, n0 = 32 * nb;
    float tv[32];
#pragma unroll
    for (int i = 0; i < 32; ++i) { const int kk = 2 * i + (lane >> 5); tv[i] = W[(size_t)(k0 + kk) * ldw + n0 + (lane & 31)]; }
#pragma unroll
    for (int i = 0; i < 32; ++i) { const int kk = 2 * i + (lane >> 5); scr[kk * 33 + (lane & 31)] = tv[i]; }
    LDS_WAIT();
    const int c = lane & 7;
#pragma unroll
    for (int j = 0; j < 4; ++j) { const int n = (lane >> 3) + 8 * j; const LAS float* s = scr + (8 * c) * 33 + n;
        v4u o; o.x = pk2(s[0 * 33], s[1 * 33]); o.y = pk2(s[2 * 33], s[3 * 33]); o.z = pk2(s[4 * 33], s[5 * 33]); o.w = pk2(s[6 * 33], s[7 * 33]);
        *(v4u*)(WT + (size_t)(row_off + n0 + n) * K + k0 + 8 * c) = o; }
    LDS_WAIT();
}

__device__ __forceinline__ void transpose_item_kp(const float* W, int ldw, int K, int ncols, bf16* WT, int dpitch, int koff, LAS float* scr, int item, int lane) {
    const int nblk = ncols / 32, kb = item / nblk, nb = item % nblk, k0 = 64 * kb, n0 = 32 * nb;
    float tv[32];
#pragma unroll
    for (int i = 0; i < 32; ++i) { const int kk = 2 * i + (lane >> 5); tv[i] = W[(size_t)(k0 + kk) * ldw + n0 + (lane & 31)]; }
#pragma unroll
    for (int i = 0; i < 32; ++i) { const int kk = 2 * i + (lane >> 5); scr[kk * 33 + (lane & 31)] = tv[i]; }
    LDS_WAIT();
    const int c = lane & 7;
#pragma unroll
    for (int j = 0; j < 4; ++j) { const int n = (lane >> 3) + 8 * j; const LAS float* s = scr + (8 * c) * 33 + n;
        v4u o; o.x = pk2(s[0 * 33], s[1 * 33]); o.y = pk2(s[2 * 33], s[3 * 33]); o.z = pk2(s[4 * 33], s[5 * 33]); o.w = pk2(s[6 * 33], s[7 * 33]);
        *(v4u*)(WT + (size_t)(n0 + n) * dpitch + koff + k0 + 8 * c) = o; }
    LDS_WAIT();
}

__device__ __forceinline__ void phase0(const Params& p, LAS unsigned char* lds, int tid, int lane, int wave) {
    unsigned char* ws = p.ws;
    { float* rowss = (float*)(ws + WS_ROWSS); for (int e = blockIdx.x * 512 + tid; e < M; e += gridDim.x * 512) rowss[e] = 0.f; }
    LAS float* scr = (LAS float*)(lds + wave * 16384);
    const int gw = blockIdx.x * NWAVES + wave, NGW = gridDim.x * NWAVES;
    const float* w_in = p.in[7];
    bf16* Win_t = (bf16*)(ws + WS_WIN);
    constexpr int I0 = 16 * 40, I1 = 16 * 48, I2 = 16 * 32, I3 = 16 * 32, I4 = 8 * 32, I5 = 8 * 32, I6 = 16 * 32, I7 = 16 * 128, I8 = 64 * 32, I9 = 32 * 2, I10 = 32 * 2;
    constexpr int NITEMS = I0 + I1 + I2 + I3 + I4 + I5 + I6 + I7 + I8 + I9 + I10;
    for (int it = gw; it < NITEMS; it += NGW) {
        int r = it;
        if (r < I0) { transpose_item(w_in, 4888, DM, 1280, Win_t, 0, scr, r, lane); continue; } r -= I0;
        if (r < I1) { transpose_item(w_in + 1304, 4888, DM, 1536, Win_t, 1280, scr, r, lane); continue; } r -= I1;
        if (r < I2) { transpose_item(w_in + 2840, 4888, DM, 1024, Win_t, 2816, scr, r, lane); continue; } r -= I2;
        if (r < I3) { transpose_item(w_in + 3864, 4888, DM, 1024, Win_t, 3840, scr, r, lane); continue; } r -= I3;
        if (r < I4) { transpose_item_kp(p.in[15], DM, 512, DM, (bf16*)(ws + WS_WUPA), DM, 0, scr, r, lane); continue; } r -= I4;
        if (r < I5) { transpose_item_kp(p.in[16], DM, 512, DM, (bf16*)(ws + WS_WUPA), DM, 512, scr, r, lane); continue; } r -= I5;
        if (r < I6) { transpose_item(p.in[17], DM, DM, DM, (bf16*)(ws + WS_WOUT), 0, scr, r, lane); continue; } r -= I6;
        if (r < I7) { transpose_item(p.in[18], FF, DM, FF, (bf16*)(ws + WS_W1), 0, scr, r, lane); continue; } r -= I7;
        if (r < I8) { transpose_item(p.in[19], DM, FF, DM, (bf16*)(ws + WS_W2), 0, scr, r, lane); continue; } r -= I8;
        if (r < I9) { transpose_item(p.in[9], 64, 2048, 64, (bf16*)(ws + WS_CW1K), 0, scr, r, lane); continue; } r -= I9;
        transpose_item(p.in[11], 64, 2048, 64, (bf16*)(ws + WS_CW1V), 0, scr, r, lane);
    }
    __syncthreads();
    LAS float* sc = (LAS float*)lds;
    LAS float* red = (LAS float*)(lds + 65536);
    float* mod = (float*)(ws + WS_MOD);
    for (int it = blockIdx.x; it < 247; it += gridDim.x) {
        if (it < 192) {
            const float* c = p.in[1]; const float* ada_w = p.in[3]; const float* ada_b = p.in[4];
            for (int e = tid; e < 16384; e += 512) { const float v = c[e]; sc[e] = v * sigm(v); }
            __syncthreads();
            const int colj = tid & 31, kg = tid >> 5, j0 = it * 32;
            float acc[16];
#pragma unroll
            for (int b = 0; b < 16; ++b) acc[b] = 0.f;
            for (int k8 = kg * 64; k8 < kg * 64 + 64; k8 += 8) {
                float w[8];
#pragma unroll
                for (int u = 0; u < 8; ++u) w[u] = ada_w[(size_t)(k8 + u) * 6144 + j0 + colj];
#pragma unroll
                for (int u = 0; u < 8; ++u)
#pragma unroll
                    for (int b = 0; b < 16; ++b) acc[b] += sc[b * 1024 + k8 + u] * w[u];
            }
#pragma unroll
            for (int b = 0; b < 16; ++b) red[(kg * 16 + b) * 32 + colj] = acc[b];
            __syncthreads();
            { const int b = tid >> 5, cj = tid & 31; float s = ada_b[j0 + cj];
#pragma unroll
              for (int k2 = 0; k2 < 16; ++k2) s += red[(k2 * 16 + b) * 32 + cj];
              mod[b * 6144 + j0 + cj] = s; }
            __syncthreads();
        } else if (it < 194) {
            const int kv = it - 192; const float* w1 = kv ? p.in[11] : p.in[9]; const float* pos = p.in[8];
            const int colj = tid & 63, kg = tid >> 6; float a = 0.f;
            for (int k16 = kg * 256; k16 < kg * 256 + 256; k16 += 16) {
                float w[16], pv_[16];
#pragma unroll
                for (int u = 0; u < 16; ++u) { w[u] = w1[(k16 + u) * 64 + colj]; pv_[u] = pos[k16 + u]; }
#pragma unroll
                for (int u = 0; u < 16; ++u) a += pv_[u] * w[u];
            }
            red[kg * 64 + colj] = a;
            __syncthreads();
            if (tid < 64) { float s = 0.f;
#pragma unroll
                for (int k2 = 0; k2 < 8; ++k2) s += red[k2 * 64 + tid];
                ((float*)(ws + WS_PW1))[kv * 64 + tid] = s; }
            __syncthreads();
        } else if (it < 218) {
            const int r = it - 194;
            for (int k = tid; k < 1024; k += 512) Win_t[(size_t)(4864 + r) * 1024 + k] = (bf16)(pk2(w_in[(size_t)k * 4888 + 1280 + r], 0.f) & 0xffffu);
        } else {
            v4u* zp = (v4u*)(Win_t + (size_t)(4888 + 8 * (it - 218)) * 1024);
            for (int e = tid; e < 8 * 1024 / 8; e += 512) zp[e] = (v4u){0u, 0u, 0u, 0u};
        }
    }
}

__device__ __forceinline__ void norm_rows(const float* src, const float* gain, const float* mod, int shift_off, int scale_off, bf16* dst, int lane, int wave) {
    const int gw = blockIdx.x * NWAVES + wave, NGW = gridDim.x * NWAVES;
    const int rpw = (M + NGW - 1) / NGW;
    const int m0 = gw * rpw, m1 = (m0 + rpw < M) ? m0 + rpw : M;
    if (m0 >= M) return;
    f32x4 gam[4], sh[4];
    int bcur = -1;
    f32x4 v[4], nx[4];
    { const f32x4* xr = (const f32x4*)(src + (size_t)m0 * DM) + lane;
#pragma unroll
      for (int j = 0; j < 4; ++j) nx[j] = xr[64 * j]; }
    for (int m = m0; m < m1; ++m) {
        const int b = m >> 12;
        if (b != bcur) { bcur = b;
#pragma unroll
            for (int j = 0; j < 4; ++j) { const int col = 4 * (lane + 64 * j);
                const f32x4 g = *(const f32x4*)(gain + col), sc = *(const f32x4*)(mod + b * 6144 + scale_off + col); sh[j] = *(const f32x4*)(mod + b * 6144 + shift_off + col);
                gam[j] = g * (sc + 1.0f); } }
#pragma unroll
        for (int j = 0; j < 4; ++j) v[j] = nx[j];
        if (m + 1 < m1) { const f32x4* xr = (const f32x4*)(src + (size_t)(m + 1) * DM) + lane;
#pragma unroll
            for (int j = 0; j < 4; ++j) nx[j] = xr[64 * j]; }
        float ss = 0.f;
#pragma unroll
        for (int j = 0; j < 4; ++j) ss += (v[j].x * v[j].x + v[j].y * v[j].y) + (v[j].z * v[j].z + v[j].w * v[j].w);
        const float rstd = rsqrtf(wave_sum(ss) * (1.0f / DM) + 1e-6f);
#pragma unroll
        for (int j = 0; j < 4; ++j) { const int col = 4 * (lane + 64 * j);
            const f32x4 u = (v[j] * rstd) * gam[j] + sh[j];
            v2u w; w.x = pk2(u.x, u.y); w.y = pk2(u.z, u.w);
            *(v2u*)(dst + (size_t)m * DM + col) = w; }
    }
}

__device__ __forceinline__ void phase3(const Params& p, LAS unsigned char* lds, int tid, int lane, int wave, bool do_norm) {
    unsigned char* ws = p.ws;
    bf16* Z = (bf16*)(ws + WS_Z);
    const int gw = blockIdx.x * NWAVES + wave, NGW = gridDim.x * NWAVES;
    {
        LAS float* hid = (LAS float*)(lds + wave * 4352);
        const int row = lane & 15, quad = lane >> 4;
        for (int task = (NGW - 1 - gw); task < 1024; task += NGW) {
            const int kv = task & 1, cg16 = (task >> 1) & 15, hkv = (task >> 5) & 1, b = task >> 6;
            const int c0 = cg16 * 16;
            const bf16* w1t = (const bf16*)(ws + (kv ? WS_CW1V : WS_CW1K));
            const float* pw1 = (const float*)(ws + WS_PW1) + kv * 64;
            const float* w2 = kv ? p.in[12] : p.in[10];
            const int zc = (kv ? ZVC : ZKC) + hkv * 64;
            int t0 = 16 * (c0 + row);
            f32x4 acc[4];
#pragma unroll
            for (int nt = 0; nt < 4; ++nt) acc[nt] = (f32x4){0.f, 0.f, 0.f, 0.f};
#pragma unroll 8
            for (int s = 0; s < 64; ++s) {
                int tk = t0 + (s >> 1); tk = tk < S ? tk : S - 1;
                const bf16x8 a = *(const bf16x8*)(Z + ((size_t)b * S + tk) * ZW + zc + (s & 1) * 32 + quad * 8);
#pragma unroll
                for (int nt = 0; nt < 4; ++nt) { const bf16x8 bb = *(const bf16x8*)(w1t + (size_t)(nt * 16 + row) * 2048 + s * 32 + quad * 8);
                    acc[nt] = __builtin_amdgcn_mfma_f32_16x16x32_bf16(a, bb, acc[nt], 0, 0, 0); }
            }
#pragma unroll
            for (int nt = 0; nt < 4; ++nt) { const float pb = pw1[nt * 16 + row];
#pragma unroll
                for (int j = 0; j < 4; ++j) { const float x = acc[nt][j] + pb; hid[(quad * 4 + j) * 68 + nt * 16 + row] = x * sigm(x); } }
            LDS_WAIT();
            float o[16];
#pragma unroll
            for (int r = 0; r < 16; ++r) o[r] = 0.f;
            for (int k = 0; k < 64; k += 4) {
                const float wa = w2[(k + 0) * 64 + lane], wb = w2[(k + 1) * 64 + lane], wc_ = w2[(k + 2) * 64 + lane], wd = w2[(k + 3) * 64 + lane];
#pragma unroll
                for (int r = 0; r < 16; ++r) { const f32x4 h = *(const LAS f32x4*)(hid + r * 68 + k); o[r] += h.x * wa + h.y * wb + h.z * wc_ + h.w * wd; }
            }
            LDS_WAIT();
            if (kv == 0) {
                const float gn = p.in[14][lane];
                bf16* KC = (bf16*)(ws + WS_KC) + ((size_t)(b * 2 + hkv) * 256 + c0) * 64 + lane;
#pragma unroll
                for (int r = 0; r < 16; ++r) { const float ss = wave_sum(o[r] * o[r]); const float rstd = rsqrtf(ss * (1.0f / 64.0f) + 1e-6f);
                    const float v = (c0 + r < 255) ? o[r] * rstd * gn : 0.f; KC[r * 64] = (bf16)(pk2(v, 0.f) & 0xffffu); }
            } else {
                bf16* VCT = (bf16*)(ws + WS_VCT) + ((size_t)(b * 2 + hkv) * 64 + lane) * 256 + c0;
                if (c0 + 15 >= 255) o[15] = 0.f;
                v4u w0, w1;
                w0.x = pk2(o[0], o[1]); w0.y = pk2(o[2], o[3]); w0.z = pk2(o[8], o[9]); w0.w = pk2(o[10], o[11]);
                w1.x = pk2(o[4], o[5]); w1.y = pk2(o[6], o[7]); w1.z = pk2(o[12], o[13]); w1.w = pk2(o[14], o[15]);
                *(v4u*)VCT = w0; *(v4u*)(VCT + 8) = w1;
            }
        }
    }
    __syncthreads();
    if (do_norm) {
        const float* qg = p.in[13]; const float* kg = p.in[14];
        const int sub = lane & 7;
        const long total = (long)M * 12;
        if (gw < NGW / 2)
        for (long base = (long)gw * 32; base < total; base += (long)(NGW / 2) * 32) {
            v4u raw[4]; v4u* ptr[4]; const float* gnp[4]; float extra[4];
#pragma unroll
            for (int u = 0; u < 4; ++u) {
                const long vi = base + u * 8 + (lane >> 3);
                const int tokn = (int)(vi / 12), which = (int)(vi - (long)tokn * 12);
                int col; extra[u] = 1.0f;
                if (which < 8) { col = ZQ + which * 64; gnp[u] = qg; extra[u] = 0.125f * LOG2E; }
                else if (which < 10) { col = ZKS + (which - 8) * 64; gnp[u] = kg + 64; }
                else { col = ZKW + (which - 10) * 64; gnp[u] = kg + 128; }
                ptr[u] = (v4u*)(Z + (size_t)tokn * ZW + col + sub * 8);
                raw[u] = *ptr[u];
            }
#pragma unroll
            for (int u = 0; u < 4; ++u) {
                const v4u rw = raw[u];
                float f[8] = {bflo(rw.x), bfhi(rw.x), bflo(rw.y), bfhi(rw.y), bflo(rw.z), bfhi(rw.z), bflo(rw.w), bfhi(rw.w)};
                float ss = 0.f;
#pragma unroll
                for (int e2 = 0; e2 < 8; ++e2) ss += f[e2] * f[e2];
                ss += __shfl_xor(ss, 1); ss += __shfl_xor(ss, 2); ss += __shfl_xor(ss, 4);
                const float rstd = rsqrtf(ss * (1.0f / 64.0f) + 1e-6f) * extra[u];
                const f32x4 g0 = *(const f32x4*)(gnp[u] + sub * 8), g1 = *(const f32x4*)(gnp[u] + sub * 8 + 4);
                v4u o; o.x = pk2(f[0] * rstd * g0.x, f[1] * rstd * g0.y); o.y = pk2(f[2] * rstd * g0.z, f[3] * rstd * g0.w);
                o.z = pk2(f[4] * rstd * g1.x, f[5] * rstd * g1.y); o.w = pk2(f[6] * rstd * g1.z, f[7] * rstd * g1.w);
                *ptr[u] = o;
            }
        }
    }
    __syncthreads();
    { LAS float* shl = (LAS float*)lds; const float* mod = (const float*)(ws + WS_MOD); const bf16* W1t = (const bf16*)(ws + WS_W1); float* sw = (float*)(ws + WS_SW);
      for (int e = tid; e < 16384; e += 512) shl[e] = mod[(e >> 10) * 6144 + 3072 + (e & 1023)];
      __syncthreads();
      for (int colx = gw; colx < FF; colx += NGW) {
          const v4u wa = *(const v4u*)(W1t + (size_t)colx * DM + lane * 16), wb = *(const v4u*)(W1t + (size_t)colx * DM + lane * 16 + 8);
          const float wv[16] = {bflo(wa.x), bfhi(wa.x), bflo(wa.y), bfhi(wa.y), bflo(wa.z), bfhi(wa.z), bflo(wa.w), bfhi(wa.w), bflo(wb.x), bfhi(wb.x), bflo(wb.y), bfhi(wb.y), bflo(wb.z), bfhi(wb.z), bflo(wb.w), bfhi(wb.w)};
          float res = 0.f;
#pragma unroll 1
          for (int bb = 0; bb < 16; ++bb) { float a = 0.f;
#pragma unroll
              for (int e4 = 0; e4 < 4; ++e4) { const f32x4 s4 = *(const LAS f32x4*)(shl + bb * 1024 + lane * 16 + e4 * 4); a += s4.x * wv[4 * e4] + s4.y * wv[4 * e4 + 1] + s4.z * wv[4 * e4 + 2] + s4.w * wv[4 * e4 + 3]; }
              a = wave_sum(a); if (lane == bb) res = a; }
          if (lane < 16) sw[(size_t)lane * FF + colx] = res;
      } }
}

constexpr int NSTG = 4, STG_BYTES = 16384, LUT_OFF = 65536, ACC_OFF = 69632, MISC4_OFF = 135168, LUT2_OFF = 137728;
#define MFMA32(a, b, c) __builtin_amdgcn_mfma_f32_32x32x16_bf16((a), (b), (c), 0, 0, 0)
#define KKOF(hf, r) (32 * (hf) + ((r) & 3) + 8 * ((r) >> 2))
constexpr float NEGBIG = -1.0e30f;

__device__ __forceinline__ void glds16(const void* gsrc, unsigned lds_dst) {
    unsigned keep;
    asm volatile("s_mov_b32 %0, m0\n\ts_mov_b32 m0, %2\n\ts_nop 0\n\tglobal_load_lds_dwordx4 %1, off\n\ts_mov_b32 m0, %0" : "=&s"(keep) : "v"(gsrc), "s"(lds_dst) : "memory");
}
#define WAITV_BAR(N) asm volatile("s_waitcnt vmcnt(" #N ")\n\ts_barrier" ::: "memory")
#define RING_WAIT(ahead) do { if ((ahead) >= 2) WAITV_BAR(4); else if ((ahead) == 1) WAITV_BAR(2); else WAITV_BAR(0); } while (0)
#define RING_WAIT4(ahead) do { if ((ahead) >= 2) WAITV_BAR(8); else if ((ahead) == 1) WAITV_BAR(4); else WAITV_BAR(0); } while (0)
#define RING_DRAIN() asm volatile("s_waitcnt vmcnt(0)" ::: "memory")

struct Ring {
    int r8, c8; unsigned base;
    __device__ __forceinline__ void init(LAS unsigned char* lds, int lane, int wave) { r8 = 8 * wave + (lane >> 3); c8 = (lane & 7) ^ ((lane >> 3) & 7); base = (unsigned)(uintptr_t)lds + (unsigned)wave * 1024u; }
    __device__ __forceinline__ void issue4(const bf16* k, const bf16* v, size_t pitch, int stage) const {
        const size_t o = (size_t)r8 * pitch + c8 * 8; const unsigned d = base + (unsigned)stage * (2u * STG_BYTES);
        glds16(k + o, (unsigned)__builtin_amdgcn_readfirstlane(d));
        glds16(v + o, (unsigned)__builtin_amdgcn_readfirstlane(d + 8192u));
        glds16(k + o + 64, (unsigned)__builtin_amdgcn_readfirstlane(d + 16384u));
        glds16(v + o + 64, (unsigned)__builtin_amdgcn_readfirstlane(d + 24576u));
    }
    __device__ __forceinline__ void issue(const bf16* k, size_t kpitch, const bf16* vt, size_t vpitch, int stage) const {
        glds16(k + (size_t)r8 * kpitch + c8 * 8, (unsigned)__builtin_amdgcn_readfirstlane(base + (unsigned)stage * STG_BYTES));
        glds16(vt + (size_t)r8 * vpitch + c8 * 8, (unsigned)__builtin_amdgcn_readfirstlane(base + (unsigned)stage * STG_BYTES + 8192u));
    }
};

__device__ __forceinline__ void qk_tile(const LAS unsigned char* kb, const bf16x8 (&qf)[4], int col, int hi, f32x16& s0, f32x16& s1, float cinit) {
    const LAS unsigned char* k0 = kb + col * 128; const int k7 = col & 7;
    bf16x8 a0[4], a1[4];
#pragma unroll
    for (int d0 = 0; d0 < 4; ++d0) { const int off = ((2 * d0 + hi) ^ k7) << 4; a0[d0] = *(const LAS bf16x8*)(k0 + off); a1[d0] = *(const LAS bf16x8*)(k0 + 32 * 128 + off); }
    asm volatile("" ::: "memory");
    f32x16 c;
#pragma unroll
    for (int r = 0; r < 16; ++r) c[r] = cinit;
    s0 = MFMA32(a0[0], qf[0], c); s1 = MFMA32(a1[0], qf[0], c);
#pragma unroll
    for (int d0 = 1; d0 < 4; ++d0) { s0 = MFMA32(a0[d0], qf[d0], s0); s1 = MFMA32(a1[d0], qf[d0], s1); }
}
__device__ __forceinline__ void qk_half_c(const LAS unsigned char* kb, const bf16x8 (&qf)[4], int col, int hi, int hf, f32x16& s, const f32x16& c) {
    const LAS unsigned char* k0 = kb + (32 * hf + col) * 128; const int k7 = col & 7;
    bf16x8 a[4];
#pragma unroll
    for (int d0 = 0; d0 < 4; ++d0) a[d0] = *(const LAS bf16x8*)(k0 + (((2 * d0 + hi) ^ k7) << 4));
    asm volatile("" ::: "memory");
    s = MFMA32(a[0], qf[0], c);
#pragma unroll
    for (int d0 = 1; d0 < 4; ++d0) s = MFMA32(a[d0], qf[d0], s);
}
__device__ __forceinline__ void qk_half(const LAS unsigned char* kb, const bf16x8 (&qf)[4], int col, int hi, int hf, f32x16& s, float cinit) {
    f32x16 c;
#pragma unroll
    for (int r = 0; r < 16; ++r) c[r] = cinit;
    qk_half_c(kb, qf, col, hi, hf, s, c);
}
__device__ __forceinline__ void pv_half(const LAS unsigned char* vb, const unsigned (&pw)[8], int col, int hi, int hf, f32x16& o0, f32x16& o1, f32x16& os, bf16x8 ones) {
    const LAS unsigned char* v0 = vb + col * 128; const int k7 = col & 7;
    bf16x8 a[2], bq[2];
#pragma unroll
    for (int s2 = 0; s2 < 2; ++s2) { const int e = ((2 * (2 * hf + s2) + hi) ^ k7) << 4; a[s2] = *(const LAS bf16x8*)(v0 + e); bq[s2] = *(const LAS bf16x8*)(v0 + 32 * 128 + e); }
    asm volatile("" ::: "memory");
#pragma unroll
    for (int s2 = 0; s2 < 2; ++s2) {
        const v4u pu = {pw[4 * s2], pw[4 * s2 + 1], pw[4 * s2 + 2], pw[4 * s2 + 3]};
        const bf16x8 pf = __builtin_bit_cast(bf16x8, pu);
        o0 = MFMA32(a[s2], pf, o0);
        o1 = MFMA32(bq[s2], pf, o1);
        os = MFMA32(ones, pf, os);
    }
}
__device__ __forceinline__ void pv_tile(const LAS unsigned char* vb, const unsigned (&pw)[16], int col, int hi, f32x16& o0, f32x16& o1) {
    const LAS unsigned char* v0 = vb + col * 128; const int k7 = col & 7;
#pragma unroll
    for (int sl = 0; sl < 4; ++sl) {
        const v4u pu = {pw[4 * sl], pw[4 * sl + 1], pw[4 * sl + 2], pw[4 * sl + 3]};
        const bf16x8 pf = __builtin_bit_cast(bf16x8, pu);
        const int e = ((2 * sl + hi) ^ k7) << 4;
        const bf16x8 a = *(const LAS bf16x8*)(v0 + e), bq = *(const LAS bf16x8*)(v0 + 32 * 128 + e);
        o0 = MFMA32(a, pf, o0);
        o1 = MFMA32(bq, pf, o1);
    }
}
typedef short v4i16_t __attribute__((ext_vector_type(4)));
__device__ __forceinline__ v2u vtr8(const LAS unsigned char* p) { return __builtin_bit_cast(v2u, __builtin_amdgcn_ds_read_tr16_b64_v4i16((LAS v4i16_t*)p)); }
struct TrAddr { int base0, ch0, ch1; };
__device__ __forceinline__ TrAddr tr_addr(int lane) {
    const int h = lane >> 5, blk = (lane >> 4) & 1, q = (lane & 15) >> 2, pp = lane & 3, r7 = 4 * h + q;
    TrAddr a; a.base0 = r7 * 128 + 8 * (pp & 1); a.ch0 = ((2 * blk + (pp >> 1)) ^ r7) << 4; a.ch1 = ((4 + 2 * blk + (pp >> 1)) ^ r7) << 4; return a;
}
__device__ __forceinline__ void pv_half_tr(const LAS unsigned char* vb, const unsigned (&pw)[8], const TrAddr& ta, int hf, f32x16& o0, f32x16& o1, f32x16& os, bf16x8 ones) {
    const LAS unsigned char* v0 = vb + ta.base0;
    v2u a0[2], a1[2], b0[2], b1[2];
#pragma unroll
    for (int s2 = 0; s2 < 2; ++s2) { const int ro = (2 * hf + s2) * 2048;
        a0[s2] = vtr8(v0 + ro + ta.ch0); a1[s2] = vtr8(v0 + ro + 1024 + ta.ch0); b0[s2] = vtr8(v0 + ro + ta.ch1); b1[s2] = vtr8(v0 + ro + 1024 + ta.ch1); }
#pragma unroll
    for (int s2 = 0; s2 < 2; ++s2) {
        const v4u pu = {pw[4 * s2], pw[4 * s2 + 1], pw[4 * s2 + 2], pw[4 * s2 + 3]};
        const bf16x8 pf = __builtin_bit_cast(bf16x8, pu);
        const v4u au = {a0[s2].x, a0[s2].y, a1[s2].x, a1[s2].y}, bu = {b0[s2].x, b0[s2].y, b1[s2].x, b1[s2].y};
        o0 = MFMA32(__builtin_bit_cast(bf16x8, au), pf, o0);
        o1 = MFMA32(__builtin_bit_cast(bf16x8, bu), pf, o1);
        os = MFMA32(ones, pf, os);
    }
}
__device__ __forceinline__ void pv_tile_tr(const LAS unsigned char* vb, const unsigned (&pw)[16], const TrAddr& ta, f32x16& o0, f32x16& o1) {
    const LAS unsigned char* v0 = vb + ta.base0;
#pragma unroll
    for (int sl = 0; sl < 4; ++sl) {
        const v4u pu = {pw[4 * sl], pw[4 * sl + 1], pw[4 * sl + 2], pw[4 * sl + 3]};
        const bf16x8 pf = __builtin_bit_cast(bf16x8, pu);
        const v2u a0 = vtr8(v0 + sl * 2048 + ta.ch0), a1 = vtr8(v0 + sl * 2048 + 1024 + ta.ch0), b0 = vtr8(v0 + sl * 2048 + ta.ch1), b1 = vtr8(v0 + sl * 2048 + 1024 + ta.ch1);
        const v4u au = {a0.x, a0.y, a1.x, a1.y}, bu = {b0.x, b0.y, b1.x, b1.y};
        o0 = MFMA32(__builtin_bit_cast(bf16x8, au), pf, o0);
        o1 = MFMA32(__builtin_bit_cast(bf16x8, bu), pf, o1);
    }
}
#define PACK_P(pw, s0, s1) do { _Pragma("unroll") for (int r_ = 0; r_ < 8; ++r_) { pw[r_] = pk2(s0[2 * r_], s0[2 * r_ + 1]); pw[8 + r_] = pk2(s1[2 * r_], s1[2 * r_ + 1]); } } while (0)
__device__ __forceinline__ int msb64(unsigned long long x) { return 63 - __builtin_clzll(x); }

__device__ __forceinline__ void nsa_unit(const Params& p, LAS unsigned char* lds, int b, int hkv, int i, int tid, int lane, int wave) {
    asm volatile("" : "+v"(tid)); lane = tid & 63;
    unsigned char* ws = p.ws;
    const bf16* Z = (const bf16*)(ws + WS_Z);
    const int col = lane & 31, hi = lane >> 5, g = col >> 3, qp = col & 7;
    const int tq = 8 * wave + qp, t = 64 * i + tq, head = 4 * hkv + g;
    const size_t tok = (size_t)b * S + t;
    const LAS float* lut = (const LAS float*)(lds + LUT_OFF) + head * 128;
    const float bias_far = lut[127];
    LAS float* impw = (LAS float*)(lds + ACC_OFF + wave * 8192);
    LAS float* impw3 = impw + 512;
    LAS float* accs = (LAS float*)(lds + ACC_OFF + wave * 8192) + lane;
    LAS unsigned long long* selor = (LAS unsigned long long*)(lds + MISC4_OFF);
    Ring rg; rg.init(lds, lane, wave);
    const TrAddr tra = tr_addr(lane);
    bf16x8 qf[4];
#pragma unroll
    for (int d0 = 0; d0 < 4; ++d0) qf[d0] = *(const bf16x8*)(Z + tok * ZW + ZQ + head * 64 + d0 * 16 + hi * 8);
    const float* gates = (const float*)(ws + WS_G) + tok * 24 + hkv * 12 + g * 3;
    const float g_c = gates[0], g_s = gates[1], g_w = gates[2];
    const LAS float* pmisc = (const LAS float*)(lds + MISC4_OFF + 2304);
    const bool fastp = pmisc[2] != 0.f;
    float qnorm;
    { float q2 = 0.f;
#pragma unroll
      for (int d0 = 0; d0 < 4; ++d0) { const v4u u = __builtin_bit_cast(v4u, qf[d0]);
          q2 += bflo(u.x) * bflo(u.x) + bfhi(u.x) * bfhi(u.x) + bflo(u.y) * bflo(u.y) + bfhi(u.y) * bfhi(u.y) + bflo(u.z) * bflo(u.z) + bfhi(u.z) * bfhi(u.z) + bflo(u.w) * bflo(u.w) + bfhi(u.w) * bfhi(u.w); }
      q2 += __shfl_xor(q2, 32);
      qnorm = sqrtf(q2) * 1.002f; }
    const bf16* KC = (const bf16*)(ws + WS_KC) + (size_t)(b * 2 + hkv) * 256 * 64;
    const bf16* VCT = (const bf16*)(ws + WS_VCT) + (size_t)(b * 2 + hkv) * 64 * 256;
    const int ntc = (i >> 4) + 1;
    const int cbase = 64 * i + tq - 31 - 64 * hi;
    float m = NEGBIG, l = 0.f;
    RING_DRAIN();
    for (int k = 0; k < 3 && k < ntc; ++k) rg.issue(KC + (size_t)k * 64 * 64, 64, VCT + k * 64, 256, k);
    for (int it = 0; it < ntc; ++it) {
        const int ahead = ntc - 1 - it;
        RING_WAIT(ahead);
        if (it + 3 < ntc) rg.issue(KC + (size_t)(it + 3) * 64 * 64, 64, VCT + (it + 3) * 64, 256, (it + 3) & 3);
        f32x16 s0, s1;
        const bool allfar = (64 * i + 8 * wave - 31 - 1024 * it - 1008) >= 128;
        float mx = NEGBIG;
        if (allfar) {
            qk_tile(lds + (it & 3) * STG_BYTES, qf, col, hi, s0, s1, bias_far);
#pragma unroll
            for (int r = 0; r < 16; ++r) mx = fmaxf(mx, fmaxf(s0[r], s1[r]));
        } else {
            qk_tile(lds + (it & 3) * STG_BYTES, qf, col, hi, s0, s1, 0.f);
            const int db = cbase - 1024 * it;
#pragma unroll
            for (int r = 0; r < 16; ++r) {
                const int d0_ = db - 16 * KKOF(0, r), d1_ = db - 16 * KKOF(1, r);
                const float x0 = s0[r] + lut[min(max(d0_, 0), 127)], x1 = s1[r] + lut[min(max(d1_, 0), 127)];
                s0[r] = d0_ >= 0 ? x0 : NEGBIG; s1[r] = d1_ >= 0 ? x1 : NEGBIG;
                mx = fmaxf(mx, fmaxf(s0[r], s1[r]));
            }
        }
        mx = fmaxf(mx, __shfl_xor(mx, 32));
        const float mn = fmaxf(m, mx);
        float ps = 0.f;
#pragma unroll
        for (int r = 0; r < 16; ++r) { ps += (s0[r] > -1.0e29f ? ex2(s0[r] - mn) : 0.f) + (s1[r] > -1.0e29f ? ex2(s1[r] - mn) : 0.f); }
        l = l * ex2(m - mn) + ps; m = mn;
    }
    WAITV_BAR(0);
    l += __shfl_xor(l, 32);
    const float inv_lc = l > 0.f ? rcp(l) : 0.f;
    f32x16 oc0, oc1;
#pragma unroll
    for (int r = 0; r < 16; ++r) { oc0[r] = 0.f; oc1[r] = 0.f; }
    for (int it = 0; it < ntc; ++it) {
        f32x16 s0, s1;
        const bool allfar = (64 * i + 8 * wave - 31 - 1024 * it - 1008) >= 128;
        if (allfar) {
            qk_tile(lds + (it & 3) * STG_BYTES, qf, col, hi, s0, s1, bias_far - m);
#pragma unroll
            for (int r = 0; r < 16; ++r) { s0[r] = ex2(s0[r]) * inv_lc; s1[r] = ex2(s1[r]) * inv_lc; }
        } else {
            qk_tile(lds + (it & 3) * STG_BYTES, qf, col, hi, s0, s1, 0.f);
            const int db = cbase - 1024 * it;
#pragma unroll
            for (int r = 0; r < 16; ++r) {
                const int d0_ = db - 16 * KKOF(0, r), d1_ = db - 16 * KKOF(1, r);
                const float x0 = s0[r] + lut[min(max(d0_, 0), 127)], x1 = s1[r] + lut[min(max(d1_, 0), 127)];
                s0[r] = d0_ >= 0 ? ex2(x0 - m) * inv_lc : 0.f; s1[r] = d1_ >= 0 ? ex2(x1 - m) * inv_lc : 0.f;
            }
        }
#pragma unroll
        for (int k4 = 0; k4 < 4; ++k4) {
            float pa0 = (s0[4 * k4] + s0[4 * k4 + 1]) + (s0[4 * k4 + 2] + 0.5f * s0[4 * k4 + 3]), pc0 = 0.5f * s0[4 * k4 + 3];
            float pa1 = (s1[4 * k4] + s1[4 * k4 + 1]) + (s1[4 * k4 + 2] + 0.5f * s1[4 * k4 + 3]), pc1 = 0.5f * s1[4 * k4 + 3];
            pa0 += __shfl_xor(pa0, 8); pa0 += __shfl_xor(pa0, 16); pc0 += __shfl_xor(pc0, 8); pc0 += __shfl_xor(pc0, 16);
            pa1 += __shfl_xor(pa1, 8); pa1 += __shfl_xor(pa1, 16); pc1 += __shfl_xor(pc1, 8); pc1 += __shfl_xor(pc1, 16);
            if (g == 0) { const int n0 = 16 * it + 2 * k4 + hi;
                impw[qp * 64 + n0] = pa0; impw3[qp * 64 + n0] = pc0; impw[qp * 64 + n0 + 8] = pa1; impw3[qp * 64 + n0 + 8] = pc1; }
        }
        unsigned pw[16]; PACK_P(pw, s0, s1);
        pv_tile(lds + (it & 3) * STG_BYTES + 8192, pw, col, hi, oc0, oc1);
    }
    LDS_WAIT();
    unsigned long long mysel = 0ull, wsel = 0ull;
    {
        const unsigned long long curmask = (i == 63) ? ~0ull : ((1ull << (i + 1)) - 1ull);
        const int want = i + 1 < 16 ? i + 1 : 16;
        const int n = lane;
        LAS float* vbuf = (LAS float*)(lds + MISC4_OFF + 256 + wave * 256);
        for (int q = 0; q < 8; ++q) {
            float v = impw[q * 64 + n] + (n > 0 ? impw3[q * 64 + n - 1] : 0.f) + ((n == 0 || n == i || n == i - 1) ? 1.0e4f : 0.f);
            v = (n <= i) ? v : -1.0e9f;
            vbuf[n] = v;
            LDS_WAIT();
            int cgt = 0;
#pragma unroll
            for (int m4 = 0; m4 < 16; ++m4) { const f32x4 w = *(const LAS f32x4*)(vbuf + 4 * m4); cgt += (w.x > v ? 1 : 0) + (w.y > v ? 1 : 0) + (w.z > v ? 1 : 0) + (w.w > v ? 1 : 0); }
            LDS_WAIT();
            unsigned long long sel = __ballot(cgt < 16) & curmask;
            if (__builtin_popcountll(sel) != want) {
                int rank = 0;
#pragma unroll 8
                for (int mm = 0; mm < 64; ++mm) { const float vm = vbuf[mm]; rank += (vm > v || (vm == v && mm < n)) ? 1 : 0; }
                LDS_WAIT();
                sel = __ballot(rank < 16) & curmask;
            }
            if (qp == q) mysel = sel;
            wsel |= sel;
        }
    }
    LDS_WAIT();
#pragma unroll
    for (int r = 0; r < 16; ++r) { accs[r * 64] = oc0[r] * g_c; accs[(16 + r) * 64] = oc1[r] * g_c; }
    if (lane == 0) selor[wave] = wsel;
    __syncthreads();
    unsigned long long U = 0ull;
#pragma unroll
    for (int w = 0; w < 8; ++w) U |= selor[w];
    U = ((unsigned long long)__builtin_amdgcn_readfirstlane((unsigned)(U >> 32)) << 32) | (unsigned long long)__builtin_amdgcn_readfirstlane((unsigned)U);
    const v4u onesu = {0x3f803f80u, 0x3f803f80u, 0x3f803f80u, 0x3f803f80u};
    const bf16x8 ones = __builtin_bit_cast(bf16x8, onesu);
    constexpr float THR = 8.0f;
#pragma unroll 1
    for (int mode = 0; mode < 2; ++mode) {
        const bf16* Kb = Z + (size_t)b * S * ZW + (mode ? ZKW : ZKS) + hkv * 64;
        const bf16* Vb = Z + (size_t)b * S * ZW + (mode ? ZVW : ZVS) + hkv * 64;
        unsigned long long Tm;
        if (mode == 0) Tm = U;
        else { const int jlo = i >= 8 ? i - 8 : 0; const unsigned long long hm = (i == 63) ? ~0ull : ((1ull << (i + 1)) - 1ull); Tm = hm & ~((1ull << jlo) - 1ull); }
        const unsigned long long wm = mode ? Tm : wsel;
        const unsigned long long lm = mode ? Tm : mysel;
        const int dmax = mode ? 512 : 0x40000000;
        f32x16 o0, o1, os, cfar;
#pragma unroll
        for (int r = 0; r < 16; ++r) { o0[r] = 0.f; o1[r] = 0.f; os[r] = 0.f; }
        float mref = fastp ? qnorm * pmisc[mode] + pmisc[8 + head] : 0.f;
#pragma unroll
        for (int r = 0; r < 16; ++r) cfar[r] = bias_far - mref;
        const int nt = __builtin_popcountll(Tm);
        unsigned long long irem = Tm, crem = Tm;
        for (int k = 0; k < 3 && k < nt; ++k) { const int ji = msb64(irem); irem &= ~(1ull << ji); rg.issue(Kb + (size_t)ji * 64 * ZW, ZW, Vb + (size_t)ji * 64 * ZW, ZW, k); }
        if (fastp) {
        for (int it = 0; it < nt; ++it) {
            const int j = msb64(crem); crem &= ~(1ull << j);
            const int ahead = nt - 1 - it;
            RING_WAIT(ahead);
            if (it + 3 < nt) { const int ji = msb64(irem); irem &= ~(1ull << ji); rg.issue(Kb + (size_t)ji * 64 * ZW, ZW, Vb + (size_t)ji * 64 * ZW, ZW, (it + 3) & 3); }
                if ((wm >> j) & 1ull) {
                    const LAS unsigned char* stg = lds + (it & 3) * STG_BYTES;
                    const int dj = i - j;
                    const bool lsel = (lm >> j) & 1ull;
                    const int db = 64 * dj + tq - 4 * hi;
#pragma unroll
                    for (int hf = 0; hf < 2; ++hf) {
                        f32x16 s; unsigned pw[8];
                        if (dj <= 2) {
                            qk_half(stg, qf, col, hi, hf, s, -mref);
                            const LAS float* l2p = (const LAS float*)(lds + LUT2_OFF) + head * 260 + db + 5;
#pragma unroll
                            for (int r = 0; r < 16; ++r) { const float x = s[r] + l2p[63 - KKOF(hf, r)]; s[r] = (lsel && KKOF(hf, r) <= db) ? ex2(x) : 0.f; }
#pragma unroll
                            for (int r = 0; r < 8; ++r) pw[r] = pk2(s[2 * r], s[2 * r + 1]);
                        } else if (dj == 8) {
                            qk_half_c(stg, qf, col, hi, hf, s, cfar);
#pragma unroll
                            for (int r = 0; r < 16; ++r) { const int d_ = db - KKOF(hf, r); s[r] = (lsel && d_ < dmax) ? ex2(s[r]) : 0.f; }
#pragma unroll
                            for (int r = 0; r < 8; ++r) pw[r] = pk2(s[2 * r], s[2 * r + 1]);
                        } else {
                            qk_half_c(stg, qf, col, hi, hf, s, cfar);
#pragma unroll
                            for (int r = 0; r < 8; ++r) { const unsigned w_ = pk2(ex2(s[2 * r]), ex2(s[2 * r + 1])); pw[r] = lsel ? w_ : 0u; }
                        }
                        pv_half_tr(stg + 8192, pw, tra, hf, o0, o1, os, ones);
                    }
                }
        }
        } else {
        for (int it = 0; it < nt; ++it) {
            const int j = msb64(crem); crem &= ~(1ull << j);
            const int ahead = nt - 1 - it;
            RING_WAIT(ahead);
            if (it + 3 < nt) { const int ji = msb64(irem); irem &= ~(1ull << ji); rg.issue(Kb + (size_t)ji * 64 * ZW, ZW, Vb + (size_t)ji * 64 * ZW, ZW, (it + 3) & 3); }
            if ((wm >> j) & 1ull) {
                const LAS unsigned char* stg = lds + (it & 3) * STG_BYTES;
                const int dj = i - j;
                const bool nearb = dj <= 2;
                const bool lsel = (lm >> j) & 1ull;
                const int db = 64 * dj + tq - 4 * hi;
#pragma unroll
                for (int hf = 0; hf < 2; ++hf) {
                    f32x16 s;
                    float mx = NEGBIG;
                    if (nearb) {
                        qk_half(stg, qf, col, hi, hf, s, -mref);
#pragma unroll
                        for (int r = 0; r < 16; ++r) { const int d_ = db - KKOF(hf, r); const float x = s[r] + lut[min(max(d_, 0), 127)]; s[r] = (lsel && d_ >= 0) ? x : NEGBIG; mx = fmaxf(mx, s[r]); }
                    } else if (dj == 8) {
                        qk_half(stg, qf, col, hi, hf, s, bias_far - mref);
#pragma unroll
                        for (int r = 0; r < 16; ++r) { const int d_ = db - KKOF(hf, r); s[r] = (lsel && d_ < dmax) ? s[r] : NEGBIG; mx = fmaxf(mx, s[r]); }
                    } else {
                        qk_half(stg, qf, col, hi, hf, s, lsel ? bias_far - mref : NEGBIG);
#pragma unroll
                        for (int r = 0; r < 16; ++r) mx = fmaxf(mx, s[r]);
                    }
                    { auto rr_ = __builtin_amdgcn_permlane32_swap(__float_as_uint(mx), __float_as_uint(mx), false, false); mx = fmaxf(__uint_as_float(rr_[0]), __uint_as_float(rr_[1])); }
                    if (dj == 0 && hf == 0) {
                        mref = mx;
#pragma unroll
                        for (int r = 0; r < 16; ++r) s[r] -= mx;
                    } else if (__any(mx > THR)) {
                        const float dl = mx > THR ? mx : 0.f; mref += dl; const float scl = ex2(-dl);
#pragma unroll
                        for (int r = 0; r < 16; ++r) s[r] -= dl;
                        o0 = o0 * scl; o1 = o1 * scl; os = os * scl;
                    }
                    unsigned pw[8];
#pragma unroll
                    for (int r = 0; r < 8; ++r) pw[r] = pk2(ex2(s[2 * r]), ex2(s[2 * r + 1]));
                    pv_half_tr(stg + 8192, pw, tra, hf, o0, o1, os, ones);
                }
            }
        }
        }
        WAITV_BAR(0);
        l = os[0];
        const float f = (mode ? g_w : g_s) * (l > 0.f ? rcp(l) : 0.f);
        if (mode == 0) {
#pragma unroll
            for (int r = 0; r < 16; ++r) { accs[r * 64] += o0[r] * f; accs[(16 + r) * 64] += o1[r] * f; }
        } else {
            bf16* O = (bf16*)(ws + WS_ATTA) + tok * 1024 + head * 64 + 4 * hi;
#pragma unroll
            for (int r = 0; r < 16; ++r) { o0[r] = accs[r * 64] + o0[r] * f; o1[r] = accs[(16 + r) * 64] + o1[r] * f; }
#pragma unroll
            for (int k4 = 0; k4 < 4; ++k4) {
                v2u w0; w0.x = pk2(o0[4 * k4], o0[4 * k4 + 1]); w0.y = pk2(o0[4 * k4 + 2], o0[4 * k4 + 3]);
                v2u w1; w1.x = pk2(o1[4 * k4], o1[4 * k4 + 1]); w1.y = pk2(o1[4 * k4 + 2], o1[4 * k4 + 3]);
                *(v2u*)(O + 8 * k4) = w0; *(v2u*)(O + 32 + 8 * k4) = w1;
            }
        }
    }
}

__device__ __forceinline__ void sb_unit(const Params& p, LAS unsigned char* lds, int b, int hp, int qb, int tid, int lane, int wave) {
    asm volatile("" : "+v"(tid)); lane = tid & 63;
    unsigned char* ws = p.ws;
    const bf16* Z = (const bf16*)(ws + WS_Z);
    const int col = lane & 31, hi = lane >> 5, w4 = wave & 3, hsel = wave >> 2, h = 2 * hp + hsel;
    const int t = 128 * qb + 32 * w4 + col;
    const size_t tok = (size_t)b * S + t;
    const int tmaxw = 128 * qb + 32 * w4 + 31;
    LAS int* flags = (LAS int*)(lds + MISC4_OFF + 128);
    Ring rg; rg.init(lds, lane, wave);
    bf16x8 qf[4];
#pragma unroll
    for (int d0 = 0; d0 < 4; ++d0) { const v4u raw = *(const v4u*)(Z + tok * ZW + ZQB + h * 64 + d0 * 16 + hi * 8);
        constexpr float QS = 0.125f * LOG2E;
        v4u sc; sc.x = pk2(bflo(raw.x) * QS, bfhi(raw.x) * QS); sc.y = pk2(bflo(raw.y) * QS, bfhi(raw.y) * QS);
        sc.z = pk2(bflo(raw.z) * QS, bfhi(raw.z) * QS); sc.w = pk2(bflo(raw.w) * QS, bfhi(raw.w) * QS);
        qf[d0] = __builtin_bit_cast(bf16x8, sc); }
    const bf16* Kb = Z + (size_t)b * S * ZW + ZKB + 2 * hp * 64;
    const bf16* Vb = Z + (size_t)b * S * ZW + ZVB + 2 * hp * 64;
    const TrAddr tra = tr_addr(lane);
    f32x16 o0, o1;
#pragma unroll
    for (int r = 0; r < 16; ++r) { o0[r] = 0.f; o1[r] = 0.f; }
    float R = 1.0f; bool dead = false;
    const int jtop = 2 * qb + 1, nt = jtop + 1;
    if (tid < 16) flags[tid] = 0;
    RING_DRAIN();
    for (int k = 0; k < 3 && k < nt; ++k) rg.issue4(Kb + (size_t)(jtop - k) * 64 * ZW, Vb + (size_t)(jtop - k) * 64 * ZW, ZW, k);
    for (int it = 0; it < nt; ++it) {
        const int j = jtop - it;
        const int ahead = nt - 1 - it;
        RING_WAIT4(ahead);
        if (it > 0) { int alld = 1;
#pragma unroll
            for (int w = 0; w < 8; ++w) alld &= flags[((it - 1) & 1) * 8 + w];
            if (alld) break; }
        if (it + 3 < nt) rg.issue4(Kb + (size_t)(j - 3) * 64 * ZW, Vb + (size_t)(j - 3) * 64 * ZW, ZW, (it + 3) & 3);
        if (!dead && 64 * j < tmaxw) {
            const LAS unsigned char* stg = lds + (it & 3) * (2 * STG_BYTES) + hsel * STG_BYTES;
            f32x16 s0, s1;
            qk_tile(stg, qf, col, hi, s0, s1, 0.f);
            const int db = t - 64 * j - 4 * hi;
            f32x16 k0, k1;
#pragma unroll
            for (int r = 0; r < 16; ++r) {
                const float e0 = ex2(fminf(s0[r], 80.f)), e1 = ex2(fminf(s1[r], 80.f));
                const float p0 = rcp(1.0f + e0), p1 = rcp(1.0f + e1);
                s0[r] = e0 * p0; s1[r] = e1 * p1;
                k0[r] = (KKOF(0, r) < db) ? p0 : 1.0f; k1[r] = (KKOF(1, r) < db) ? p1 : 1.0f;
            }
            float g4[8], pg[8], E[8];
#pragma unroll
            for (int k4 = 0; k4 < 4; ++k4) { g4[k4] = (k0[4 * k4] * k0[4 * k4 + 1]) * (k0[4 * k4 + 2] * k0[4 * k4 + 3]); g4[4 + k4] = (k1[4 * k4] * k1[4 * k4 + 1]) * (k1[4 * k4 + 2] * k1[4 * k4 + 3]); }
#pragma unroll
            for (int G = 0; G < 8; ++G) pg[G] = __shfl_xor(g4[G], 32);
            E[7] = 1.0f;
#pragma unroll
            for (int G = 6; G >= 0; --G) E[G] = E[G + 1] * (g4[G + 1] * pg[G + 1]);
            const float T = E[0] * (g4[0] * pg[0]);
#pragma unroll
            for (int G = 0; G < 8; ++G) {
                const float base = R * E[G] * (hi == 0 ? pg[G] : 1.0f);
                const int k4 = G & 3;
                if (G < 4) {
                    const float u3 = base, u2 = u3 * k0[4 * k4 + 3], u1 = u2 * k0[4 * k4 + 2], u0 = u1 * k0[4 * k4 + 1];
                    s0[4 * k4 + 3] = (KKOF(0, 4 * k4 + 3) < db) ? s0[4 * k4 + 3] * u3 : 0.f;
                    s0[4 * k4 + 2] = (KKOF(0, 4 * k4 + 2) < db) ? s0[4 * k4 + 2] * u2 : 0.f;
                    s0[4 * k4 + 1] = (KKOF(0, 4 * k4 + 1) < db) ? s0[4 * k4 + 1] * u1 : 0.f;
                    s0[4 * k4 + 0] = (KKOF(0, 4 * k4 + 0) < db) ? s0[4 * k4 + 0] * u0 : 0.f;
                } else {
                    const float u3 = base, u2 = u3 * k1[4 * k4 + 3], u1 = u2 * k1[4 * k4 + 2], u0 = u1 * k1[4 * k4 + 1];
                    s1[4 * k4 + 3] = (KKOF(1, 4 * k4 + 3) < db) ? s1[4 * k4 + 3] * u3 : 0.f;
                    s1[4 * k4 + 2] = (KKOF(1, 4 * k4 + 2) < db) ? s1[4 * k4 + 2] * u2 : 0.f;
                    s1[4 * k4 + 1] = (KKOF(1, 4 * k4 + 1) < db) ? s1[4 * k4 + 1] * u1 : 0.f;
                    s1[4 * k4 + 0] = (KKOF(1, 4 * k4 + 0) < db) ? s1[4 * k4 + 0] * u0 : 0.f;
                }
            }
            R *= T;
            unsigned pw[16]; PACK_P(pw, s0, s1);
            pv_tile_tr(stg + 8192, pw, tra, o0, o1);
            dead = __all(R < 1.0e-44f);
        }
        if (lane == 0) flags[(it & 1) * 8 + wave] = dead ? 1 : 0;
    }
    WAITV_BAR(0);
    bf16* O = (bf16*)(ws + WS_ATTA) + tok * 1024 + 512 + h * 64 + 4 * hi;
#pragma unroll
    for (int k4 = 0; k4 < 4; ++k4) {
        v2u w0; w0.x = pk2(o0[4 * k4], o0[4 * k4 + 1]); w0.y = pk2(o0[4 * k4 + 2], o0[4 * k4 + 3]);
        v2u w1; w1.x = pk2(o1[4 * k4], o1[4 * k4 + 1]); w1.y = pk2(o1[4 * k4 + 2], o1[4 * k4 + 3]);
        *(v2u*)(O + 8 * k4) = w0; *(v2u*)(O + 32 + 8 * k4) = w1;
    }
}

__device__ __forceinline__ void phase4(const Params& p, LAS unsigned char* lds, int tid, int lane, int wave) {
    for (int vb = blockIdx.x; vb < 256; vb += gridDim.x) {
    const int v = (vb & 7) * 32 + (vb >> 3);
    __syncthreads();
    { const float* rel = p.in[2]; LAS float* lut = (LAS float*)(lds + LUT_OFF);
      for (int e = tid; e < 1024; e += 512) { const int head = e >> 7, dist = e & 127;
          int bk = dist; if (dist >= 16) { bk = 16 + (int)(logf((float)dist / 16.0f) / 2.0794415416798357f * 16.0f); bk = bk < 31 ? bk : 31; }
          lut[e] = rel[bk * 8 + head] * LOG2E; } }
    __syncthreads();
    { const LAS float* lut = (const LAS float*)(lds + LUT_OFF); LAS float* l2 = (LAS float*)(lds + LUT2_OFF);
      for (int e = tid; e < 8 * 260; e += 512) { const int head = e / 260, d = e % 260 - 68; l2[e] = d < 0 ? 0.f : lut[head * 128 + (d < 127 ? d : 127)]; } }
    if (wave == 0) { const float* qg = p.in[13]; const float* kg = p.in[14]; LAS float* pm = (LAS float*)(lds + MISC4_OFF + 2304); const LAS float* lut = (const LAS float*)(lds + LUT_OFF);
        float a = fabsf(qg[lane]), b1 = fabsf(kg[64 + lane]), b2 = fabsf(kg[128 + lane]);
#pragma unroll
        for (int o = 1; o < 64; o <<= 1) { a = fmaxf(a, __shfl_xor(a, o)); b1 = fmaxf(b1, __shfl_xor(b1, o)); b2 = fmaxf(b2, __shfl_xor(b2, o)); }
        float bm = -1.0e30f, ball = 0.f;
        if (lane < 8) {
            for (int d = 0; d < 128; ++d) bm = fmaxf(bm, lut[lane * 128 + d]);
            pm[8 + lane] = bm; }
        ball = lane < 8 ? bm : -1.0e30f;
#pragma unroll
        for (int o = 1; o < 64; o <<= 1) ball = fmaxf(ball, __shfl_xor(ball, o));
        const float kn1 = 8.0f * b1 * 1.004f, kn2 = 8.0f * b2 * 1.004f, qmax = 8.0f * a * 0.125f * LOG2E * 1.004f;
        const float worst = qmax * fmaxf(kn1, kn2) + fmaxf(ball, 0.f);
        if (lane == 0) { pm[0] = kn1; pm[1] = kn2; pm[2] = (worst < 48.0f) ? 1.0f : 0.0f; } }
    __syncthreads();
        { const int pair = v >> 3, s = v & 7, b = pair >> 1, hkv = pair & 1;
#pragma unroll 1
          for (int u = 0; u < 8; ++u) { const int i = (u & 1) ? (16 * (u >> 1) + 15 - s) : (16 * (u >> 1) + s);
 for (int rep_ = 0; rep_ < REP_NSA; ++rep_) nsa_unit(p, lds, b, hkv, i, tid, lane, wave);
 } }
        { const int pair = v >> 2, b = pair >> 2, hp = pair & 3;
#pragma unroll 1
          for (int u = 0; u < 8; ++u) { const int qb = (v & 3) + 4 * u;
 for (int rep_ = 0; rep_ < REP_SB; ++rep_) sb_unit(p, lds, b, hp, qb, tid, lane, wave);
 } }
    }
}

__global__ void __launch_bounds__(NWAVES * 64, 2) fwd_megakernel(Params p) {
    extern __shared__ __attribute__((aligned(16))) unsigned char lds_raw[];
    LAS unsigned char* lds = (LAS unsigned char*)lds_raw;
    cg::grid_group grid = cg::this_grid();
    int tid = threadIdx.x, lane = tid & 63, wave = __builtin_amdgcn_readfirstlane(tid >> 6);
#define RELAUNDER() do { tid = threadIdx.x; asm volatile("" : "+v"(tid)); lane = tid & 63; wave = __builtin_amdgcn_readfirstlane(tid >> 6); } while (0)
    unsigned char* ws = p.ws;
    bf16* XN = (bf16*)(ws + WS_XN); bf16* Zb = (bf16*)(ws + WS_Z); float* mod = (float*)(ws + WS_MOD);
    const int G = gridDim.x;

    RELAUNDER();
    for (int rep_ = 0; rep_ < REP_P0; ++rep_) { phase0(p, lds, tid, lane, wave); __syncthreads(); }
    grid.sync();
    RELAUNDER();
    for (int rep_ = 0; rep_ < REP_P1; ++rep_) norm_rows(p.in[0], p.in[5], mod, 0, 1024, XN, lane, wave);
    grid.sync();
    { pg8::Gemm g{XN, (const bf16*)(ws + WS_WIN), M, NIN, DM}; pg8::StaticOrder So; So.init(M, NIN, G, (int)blockIdx.x);
      pg8::EpiZ E{Zb, (float*)(ws + WS_G)};
      pg8::gemm_phase<pg8::EpiZ, pg8::StaticOrder, true, true>(lds, g, So, E); }
    grid.sync();
    RELAUNDER();
    for (int rep_ = 0; rep_ < REP_P3; ++rep_) { phase3(p, lds, tid, lane, wave, rep_ == 0); __syncthreads(); }
    grid.sync();
    RELAUNDER();
#ifndef SKIP_P4
    phase4(p, lds, tid, lane, wave);
#endif
    grid.sync();
    { pg8::Gemm g{(const bf16*)(ws + WS_ATTA), (const bf16*)(ws + WS_WUPA), M, DM, DM}; pg8::StaticOrder So; So.init(M, DM, G, (int)blockIdx.x);
      pg8::EpiUpF E{XN, Zb};
      pg8::gemm_phase<pg8::EpiUpF, pg8::StaticOrder, true, true>(lds, g, So, E); }
    grid.sync();
    { pg8::Gemm g{XN, (const bf16*)(ws + WS_WOUT), M, DM, DM}; pg8::StaticOrder So; So.init(M, DM, G, (int)blockIdx.x);
      pg8::EpiRes2 E{p.in[0], p.out, mod + 2048, p.in[6], mod + 4096, (bf16*)(ws + WS_ATTA), (float*)(ws + WS_ROWSS)};
      pg8::gemm_phase<pg8::EpiRes2, pg8::StaticOrder, true, true>(lds, g, So, E); }
    grid.sync();
    { pg8::Gemm g{(const bf16*)(ws + WS_ATTA), (const bf16*)(ws + WS_W1), M, FF, DM}; pg8::StaticOrder So; So.init(M, FF, G, (int)blockIdx.x);
      pg8::EpiRelu2N E{Zb, (const float*)(ws + WS_ROWSS), (const float*)(ws + WS_SW)};
      pg8::gemm_phase<pg8::EpiRelu2N, pg8::StaticOrder, true, true>(lds, g, So, E); }
    grid.sync();
    { pg8::Gemm g{Zb, (const bf16*)(ws + WS_W2), M, DM, FF}; pg8::StaticOrder So; So.init(M, DM, G, (int)blockIdx.x);
      pg8::EpiRes E{p.out, p.out, mod + 5120};
      pg8::gemm_phase<pg8::EpiRes, pg8::StaticOrder, true, true>(lds, g, So, E); }
}

extern "C" void kernel_launch(void* const* d_in, const int* in_sizes, int n_in, void* d_out, int out_size, void* d_ws, size_t ws_size, hipStream_t stream) {
    static int grid = 0;
    if (grid == 0) {
        if (n_in != 20 || ws_size < WS_END) { fprintf(stderr, "kernel_launch: unexpected inputs (n_in %d, ws %zu)\n", n_in, ws_size); grid = -1; return; }
        int dev = 0, cus = 0, per_cu = 0;
        hipGetDevice(&dev); hipDeviceGetAttribute(&cus, hipDeviceAttributeMultiprocessorCount, dev);
        if (hipFuncSetAttribute((const void*)fwd_megakernel, hipFuncAttributeMaxDynamicSharedMemorySize, LDS_BYTES) != hipSuccess) fprintf(stderr, "kernel_launch: hipFuncSetAttribute failed\n");
        if (hipOccupancyMaxActiveBlocksPerMultiprocessor(&per_cu, (const void*)fwd_megakernel, NWAVES * 64, LDS_BYTES) != hipSuccess || per_cu < 1) { fprintf(stderr, "kernel_launch: occupancy query gave %d\n", per_cu); per_cu = 1; }
        (void)hipGetLastError();
        grid = cus * per_cu;
    }
    if (grid < 0) return;
    Params p{};
    for (int i = 0; i < 20; ++i) p.in[i] = (const float*)d_in[i];
    p.out = (float*)d_out; p.ws = (unsigned char*)d_ws;
    void* args[] = {&p};
    hipError_t e = hipLaunchCooperativeKernel((const void*)fwd_megakernel, dim3(grid), dim3(NWAVES * 64), args, LDS_BYTES, stream);
    if (e != hipSuccess) fprintf(stderr, "kernel_launch: cooperative launch failed: %s (grid %d)\n", hipGetErrorString(e), grid);
}
```

```cpp
#include <hip/hip_runtime.h>
#include <hip/hip_cooperative_groups.h>
#include <cstdio>
#include <cstdint>
namespace cg = cooperative_groups;

constexpr int NB = 16, S = 4096, DM = 1024, M = NB * S, FF = 4096;
constexpr int ZW = 4864;
constexpr int ZQ = 0, ZKC = 512, ZVC = 640, ZKS = 768, ZVS = 896, ZKW = 1024, ZVW = 1152, ZQB = 1280, ZKB = 1792, ZVB = 2304, ZMA = 2816, ZMB = 3840;
constexpr int NIN = 5120;
constexpr size_t MiB = (size_t)1 << 20;
constexpr size_t WS_WIN = 1 * MiB, WS_WUPA = 11 * MiB, WS_WUPB = 12 * MiB, WS_WOUT = 13 * MiB, WS_W1 = 15 * MiB, WS_W2 = 23 * MiB;
constexpr size_t WS_MOD = 31 * MiB, WS_PW1 = 31 * MiB + 400 * 1024, WS_CW1K = 31 * MiB + 512 * 1024, WS_CW1V = WS_CW1K + 256 * 1024;
constexpr size_t WS_KC = 32 * MiB, WS_VCT = 33 * MiB, WS_VST = 34 * MiB, WS_VWT = 50 * MiB, WS_VBT = 66 * MiB;
constexpr size_t WS_XN = 130 * MiB, WS_ATTA = 258 * MiB, WS_ATTB = 322 * MiB, WS_Z = 386 * MiB, WS_G = 994 * MiB, WS_ROWSS = 1000 * MiB, WS_SW = 1001 * MiB, WS_END = 1002 * MiB;
constexpr float LOG2E = 1.4426950408889634f, LN2 = 0.6931471805599453f;
#ifndef REP_NSA
#define REP_NSA 1
#endif
#ifndef REP_SB
#define REP_SB 1
#endif
#define REP_P0 1
#define REP_P1 1
#define REP_P3 1
namespace pg8 {
#define PG8_LAS __attribute__((address_space(3)))
typedef unsigned short bf16_t;
typedef short bf16x8 __attribute__((ext_vector_type(8)));
typedef float f32x4 __attribute__((ext_vector_type(4)));
typedef unsigned u32x4 __attribute__((ext_vector_type(4)));
constexpr int BM = 256, BK = 64, HALF = 128, HTB = HALF * BK * 2  , STAGE_BYTES = 8 * HTB, NXCD = 8, WGM = 8;

__host__ __device__ __forceinline__ int lds_byte(int r, int c) { const int st = (r >> 4) * 2 + (c >> 5), rr = r & 15, cc = c & 31, ob = rr * 64 + cc * 2; return st * 1024 + (ob ^ (((ob >> 9) & 1) << 5)); }
__host__ __device__ __forceinline__ void stage_rc(int b, int& R, int& C) { const int st = b / 1024, sb = b % 1024, swz = sb ^ (((sb >> 9) & 1) << 5); R = (st >> 1) * 16 + swz / 64; C = (st & 1) * 32 + (swz % 64) / 2; }
__host__ __device__ __forceinline__ int perm32(int rho) { const int n = rho >> 4, i = rho & 15; return 8 * (i >> 2) + 4 * n + (i & 3); }

struct Unit { int pm, pn; };
struct Gemm { const bf16_t* A; const bf16_t* Bt; int M, N, K; };

struct StaticOrder {
    int nM, nN, nwg, G, c;
    __host__ __device__ void init(int M, int N, int G_, int c_) { nM = M / BM; nN = N / BM; nwg = nM * nN; G = G_; c = c_; }
    __host__ __device__ bool next(int i, Unit& u) const {
        const long L = (long)i * G + c; if (L >= nwg) return false;
        int wgid = (int)L; { const int q = nwg / NXCD, r = nwg % NXCD, xcd = wgid % NXCD, off = wgid / NXCD; wgid = (xcd < r ? xcd * (q + 1) : r * (q + 1) + (xcd - r) * q) + off; }
        const int nig = WGM * nN, gid = wgid / nig, fm = gid * WGM, gsz = (nM - fm) < WGM ? (nM - fm) : WGM;
        u.pm = fm + ((wgid % nig) % gsz); u.pn = (wgid % nig) / gsz; return true;
    }
    __device__ __forceinline__ void a_ready(const Unit&) const {}
    __device__ __forceinline__ void done(const Unit&) const {}
};

__device__ __forceinline__ unsigned cvt_pk_bf16(float lo, float hi) { unsigned r; asm volatile("v_cvt_pk_bf16_f32 %0, %1, %2" : "=v"(r) : "v"(lo), "v"(hi)); return r; }
__device__ __forceinline__ float sigm(float x) { return __builtin_amdgcn_rcpf(1.0f + __builtin_amdgcn_exp2f(-1.4426950408889634f * x)); }
__device__ __forceinline__ float bflo(unsigned u) { return __uint_as_float(u << 16); }
__device__ __forceinline__ float bfhi(unsigned u) { return __uint_as_float(u & 0xffff0000u); }
struct EpiZ {
    static constexpr bool PERM = true, AFTER_DRAIN = false, HAS_MID = false;
    bf16_t* Z; float* G;
    __device__ __forceinline__ void operator()(const f32x4 (&acc)[2][2][4][2], const Unit& u, int wr, int wc, int fr, int fq) const {
        const int row0 = u.pm * BM + wr * 64 + fr; const int colt = u.pn * BM + wc * 32 + 8 * fq;
        if (u.pn < 19) {
            const bool sg = u.pn >= 11;
#pragma unroll
            for (int ai = 0; ai < 2; ++ai)
#pragma unroll
                for (int m = 0; m < 4; ++m) { bf16_t* rowp = Z + (size_t)(row0 + ai * HALF + m * 16) * ZW + colt;
#pragma unroll
                    for (int bj = 0; bj < 2; ++bj) { f32x4 v0 = acc[ai][bj][m][0], v1 = acc[ai][bj][m][1];
                        if (sg) { v0 = (f32x4){sigm(v0[0]), sigm(v0[1]), sigm(v0[2]), sigm(v0[3])}; v1 = (f32x4){sigm(v1[0]), sigm(v1[1]), sigm(v1[2]), sigm(v1[3])}; }
                        u32x4 w; w.x = cvt_pk_bf16(v0[0], v0[1]); w.y = cvt_pk_bf16(v0[2], v0[3]); w.z = cvt_pk_bf16(v1[0], v1[1]); w.w = cvt_pk_bf16(v1[2], v1[3]);
                        *(u32x4*)(rowp + bj * HALF) = w; } }
        } else if (wc == 0 && fq < 3) {
#pragma unroll
            for (int ai = 0; ai < 2; ++ai)
#pragma unroll
                for (int m = 0; m < 4; ++m) { float* gp = G + (size_t)(row0 + ai * HALF + m * 16) * 24 + 8 * fq; const f32x4 v0 = acc[ai][0][m][0], v1 = acc[ai][0][m][1];
                    *(f32x4*)gp = (f32x4){sigm(v0[0]), sigm(v0[1]), sigm(v0[2]), sigm(v0[3])}; *(f32x4*)(gp + 4) = (f32x4){sigm(v1[0]), sigm(v1[1]), sigm(v1[2]), sigm(v1[3])}; }
        }
    }
};
__device__ __forceinline__ float gclamp(float g) { return g > 1.0e-20f ? g : 1.0e-20f; }
struct EpiUpF {
    static constexpr bool PERM = true, AFTER_DRAIN = false, HAS_MID = true;
    bf16_t* Y; const bf16_t* Zg;
    __device__ __forceinline__ void mid(f32x4 (&acc)[2][2][4][2], const Unit& u, int wr, int wc, int fr, int fq) const {
        int row0 = u.pm * BM + wr * 64 + fr; int colt = u.pn * BM + wc * 32 + 8 * fq;
        asm volatile("" : "+v"(row0), "+v"(colt));
#pragma unroll
        for (int ai = 0; ai < 2; ++ai)
#pragma unroll
            for (int m = 0; m < 4; ++m) { const size_t row = (size_t)(row0 + ai * HALF + m * 16);
#pragma unroll
                for (int bj = 0; bj < 2; ++bj) { const int col = colt + bj * HALF;
                    const u32x4 ga = *(const u32x4*)(Zg + row * ZW + ZMA + col), gb = *(const u32x4*)(Zg + row * ZW + ZMB + col);
                    f32x4& a0 = acc[ai][bj][m][0]; f32x4& a1 = acc[ai][bj][m][1];
                    a0[0] *= bflo(ga.x) * __builtin_amdgcn_rcpf(gclamp(bflo(gb.x))); a0[1] *= bfhi(ga.x) * __builtin_amdgcn_rcpf(gclamp(bfhi(gb.x)));
                    a0[2] *= bflo(ga.y) * __builtin_amdgcn_rcpf(gclamp(bflo(gb.y))); a0[3] *= bfhi(ga.y) * __builtin_amdgcn_rcpf(gclamp(bfhi(gb.y)));
                    a1[0] *= bflo(ga.z) * __builtin_amdgcn_rcpf(gclamp(bflo(gb.z))); a1[1] *= bfhi(ga.z) * __builtin_amdgcn_rcpf(gclamp(bfhi(gb.z)));
                    a1[2] *= bflo(ga.w) * __builtin_amdgcn_rcpf(gclamp(bflo(gb.w))); a1[3] *= bfhi(ga.w) * __builtin_amdgcn_rcpf(gclamp(bfhi(gb.w))); }
                if (m & 1) asm volatile("" ::: "memory"); }
    }
    __device__ __forceinline__ void operator()(const f32x4 (&acc)[2][2][4][2], const Unit& u, int wr, int wc, int fr, int fq) const {
        const int row0 = u.pm * BM + wr * 64 + fr; const int colt = u.pn * BM + wc * 32 + 8 * fq;
#pragma unroll
        for (int ai = 0; ai < 2; ++ai)
#pragma unroll
            for (int m = 0; m < 4; ++m) { const size_t row = (size_t)(row0 + ai * HALF + m * 16);
#pragma unroll
                for (int bj = 0; bj < 2; ++bj) { const int col = colt + bj * HALF; const u32x4 gt = *(const u32x4*)(Zg + row * ZW + ZMB + col);
                    const f32x4 a0 = acc[ai][bj][m][0], a1 = acc[ai][bj][m][1];
                    u32x4 w; w.x = cvt_pk_bf16(a0[0] * gclamp(bflo(gt.x)), a0[1] * gclamp(bfhi(gt.x))); w.y = cvt_pk_bf16(a0[2] * gclamp(bflo(gt.y)), a0[3] * gclamp(bfhi(gt.y)));
                    w.z = cvt_pk_bf16(a1[0] * gclamp(bflo(gt.z)), a1[1] * gclamp(bfhi(gt.z))); w.w = cvt_pk_bf16(a1[2] * gclamp(bflo(gt.w)), a1[3] * gclamp(bfhi(gt.w)));
                    *(u32x4*)(Y + row * DM + col) = w; }
                if (m & 1) asm volatile("" ::: "memory"); }
    }
};
struct EpiRes {
    static constexpr bool PERM = true, AFTER_DRAIN = false, HAS_MID = false;
    const float* base; float* out; const float* gate;
    __device__ __forceinline__ void operator()(const f32x4 (&acc)[2][2][4][2], const Unit& u, int wr, int wc, int fr, int fq) const {
        const int row0 = u.pm * BM + wr * 64 + fr; const int colt = u.pn * BM + wc * 32 + 8 * fq; const int b = (u.pm * BM) >> 12;
        f32x4 bv[2][4];
#define ER_LOAD(buf, k_) do { const int bj_ = (k_) >> 2, ai_ = ((k_) >> 1) & 1, n_ = (k_) & 1; _Pragma("unroll") for (int m = 0; m < 4; ++m) bv[buf][m] = *(const f32x4*)(base + (size_t)(row0 + ai_ * HALF + m * 16) * DM + colt + bj_ * HALF + 4 * n_); } while (0)
        ER_LOAD(0, 0);
#pragma unroll
        for (int k = 0; k < 8; ++k) { const int bj = k >> 2, ai = (k >> 1) & 1, n = k & 1, cb = k & 1;
            if (k + 1 < 8) ER_LOAD(cb ^ 1, k + 1);
            const f32x4 g = *(const f32x4*)(gate + (size_t)b * 6144 + colt + bj * HALF + 4 * n);
            asm volatile("" ::: "memory");
#pragma unroll
            for (int m = 0; m < 4; ++m) *(f32x4*)(out + (size_t)(row0 + ai * HALF + m * 16) * DM + colt + bj * HALF + 4 * n) = bv[cb][m] + g * acc[ai][bj][m][n];
            asm volatile("" ::: "memory"); }
#undef ER_LOAD
    }
};
struct EpiRelu2 {
    static constexpr bool PERM = true, AFTER_DRAIN = false, HAS_MID = false;
    bf16_t* H;
    __device__ __forceinline__ void operator()(const f32x4 (&acc)[2][2][4][2], const Unit& u, int wr, int wc, int fr, int fq) const {
        const int row0 = u.pm * BM + wr * 64 + fr; const int colt = u.pn * BM + wc * 32 + 8 * fq;
#pragma unroll
        for (int ai = 0; ai < 2; ++ai)
#pragma unroll
            for (int m = 0; m < 4; ++m) { bf16_t* rowp = H + (size_t)(row0 + ai * HALF + m * 16) * FF + colt;
#pragma unroll
                for (int bj = 0; bj < 2; ++bj) { f32x4 v0 = acc[ai][bj][m][0], v1 = acc[ai][bj][m][1];
                    v0 = __builtin_elementwise_max(v0, (f32x4){0.f, 0.f, 0.f, 0.f}); v1 = __builtin_elementwise_max(v1, (f32x4){0.f, 0.f, 0.f, 0.f}); v0 = v0 * v0; v1 = v1 * v1;
                    u32x4 w; w.x = cvt_pk_bf16(v0[0], v0[1]); w.y = cvt_pk_bf16(v0[2], v0[3]); w.z = cvt_pk_bf16(v1[0], v1[1]); w.w = cvt_pk_bf16(v1[2], v1[3]);
                    *(u32x4*)(rowp + bj * HALF) = w; } }
    }
};
struct EpiRes2 {
    static constexpr bool PERM = true, AFTER_DRAIN = false, HAS_MID = false;
    const float* base; float* out; const float* gate; const float* g2; const float* scale2; bf16_t* XN2; float* rowss;
    __device__ __forceinline__ void operator()(const f32x4 (&acc)[2][2][4][2], const Unit& u, int wr, int wc, int fr, int fq) const {
        const int row0 = u.pm * BM + wr * 64 + fr; const int colt = u.pn * BM + wc * 32 + 8 * fq; const int b = (u.pm * BM) >> 12;
        float ss[8];
#pragma unroll
        for (int r = 0; r < 8; ++r) ss[r] = 0.f;
#pragma unroll
        for (int bj = 0; bj < 2; ++bj) { const int c = colt + bj * HALF;
            const f32x4 gt0 = *(const f32x4*)(gate + (size_t)b * 6144 + c), gt1 = *(const f32x4*)(gate + (size_t)b * 6144 + c + 4);
            const f32x4 gm0 = *(const f32x4*)(g2 + c) * (*(const f32x4*)(scale2 + (size_t)b * 6144 + c) + 1.0f), gm1 = *(const f32x4*)(g2 + c + 4) * (*(const f32x4*)(scale2 + (size_t)b * 6144 + c + 4) + 1.0f);
#pragma unroll
            for (int ai = 0; ai < 2; ++ai) {
                f32x4 bv[4][2];
#pragma unroll
                for (int m = 0; m < 4; ++m) { const size_t off = (size_t)(row0 + ai * HALF + m * 16) * DM + c; bv[m][0] = *(const f32x4*)(base + off); bv[m][1] = *(const f32x4*)(base + off + 4); }
                asm volatile("" ::: "memory");
#pragma unroll
                for (int m = 0; m < 4; ++m) { const size_t off = (size_t)(row0 + ai * HALF + m * 16) * DM + c;
                    const f32x4 h0 = bv[m][0] + gt0 * acc[ai][bj][m][0], h1 = bv[m][1] + gt1 * acc[ai][bj][m][1];
                    *(f32x4*)(out + off) = h0; *(f32x4*)(out + off + 4) = h1;
                    ss[ai * 4 + m] += (h0[0] * h0[0] + h0[1] * h0[1]) + (h0[2] * h0[2] + h0[3] * h0[3]) + (h1[0] * h1[0] + h1[1] * h1[1]) + (h1[2] * h1[2] + h1[3] * h1[3]);
                    const f32x4 v0 = h0 * gm0, v1 = h1 * gm1;
                    u32x4 w; w.x = cvt_pk_bf16(v0[0], v0[1]); w.y = cvt_pk_bf16(v0[2], v0[3]); w.z = cvt_pk_bf16(v1[0], v1[1]); w.w = cvt_pk_bf16(v1[2], v1[3]);
                    *(u32x4*)(XN2 + off) = w; }
                asm volatile("" ::: "memory"); } }
#pragma unroll
        for (int r = 0; r < 8; ++r) { float s = ss[r]; s += __shfl_xor(s, 16); s += __shfl_xor(s, 32);
            if (fq == 0) atomicAdd(rowss + row0 + (r >> 2) * HALF + (r & 3) * 16, s); }
    }
};
struct EpiRelu2N {
    static constexpr bool PERM = true, AFTER_DRAIN = false, HAS_MID = false;
    bf16_t* H; const float* rowss; const float* sw;
    __device__ __forceinline__ void operator()(const f32x4 (&acc)[2][2][4][2], const Unit& u, int wr, int wc, int fr, int fq) const {
        const int row0 = u.pm * BM + wr * 64 + fr; const int colt = u.pn * BM + wc * 32 + 8 * fq; const int b = (u.pm * BM) >> 12;
        float rstd[8];
#pragma unroll
        for (int r = 0; r < 8; ++r) rstd[r] = __builtin_amdgcn_rsqf(rowss[row0 + (r >> 2) * HALF + (r & 3) * 16] * (1.0f / DM) + 1e-6f);
#pragma unroll
        for (int bj = 0; bj < 2; ++bj) { const f32x4 sv0 = *(const f32x4*)(sw + (size_t)b * FF + colt + bj * HALF), sv1 = *(const f32x4*)(sw + (size_t)b * FF + colt + bj * HALF + 4);
#pragma unroll
            for (int ai = 0; ai < 2; ++ai)
#pragma unroll
                for (int m = 0; m < 4; ++m) { bf16_t* rowp = H + (size_t)(row0 + ai * HALF + m * 16) * FF + colt + bj * HALF;
                    f32x4 v0 = acc[ai][bj][m][0] * rstd[ai * 4 + m] + sv0, v1 = acc[ai][bj][m][1] * rstd[ai * 4 + m] + sv1;
                    v0 = __builtin_elementwise_max(v0, (f32x4){0.f, 0.f, 0.f, 0.f}); v1 = __builtin_elementwise_max(v1, (f32x4){0.f, 0.f, 0.f, 0.f}); v0 = v0 * v0; v1 = v1 * v1;
                    u32x4 w; w.x = cvt_pk_bf16(v0[0], v0[1]); w.y = cvt_pk_bf16(v0[2], v0[3]); w.z = cvt_pk_bf16(v1[0], v1[1]); w.w = cvt_pk_bf16(v1[2], v1[3]);
                    *(u32x4*)rowp = w; } }
    }
};
template <class Epi, class Sched, bool ALIGN_EPI = false, bool SP2 = false>
__device__ __forceinline__ void gemm_phase(PG8_LAS unsigned char* lds, const Gemm g, const Sched& S, const Epi& E) {
    int tid_ = threadIdx.x; asm volatile("" : "+v"(tid_));
    const int tid = tid_, wid = __builtin_amdgcn_readfirstlane(tid >> 6), lane = tid & 63, wr = wid >> 2, wc = wid & 3, fr = lane & 15, fq = lane >> 4;
    const int K = g.K, nt = K / BK;
    unsigned voffA[2], voffB[2];
#pragma unroll
    for (int i = 0; i < 2; ++i) { int R, C; stage_rc(tid * 16 + i * 8192, R, C); const int Rb = Epi::PERM ? ((R & ~31) + perm32(R & 31)) : R;
        voffA[i] = (unsigned)(R * K + C) * 2u; voffB[i] = (unsigned)(Rb * K + C) * 2u; }
    const size_t kstep = (size_t)(BK * 2);
    const size_t hstep = (size_t)HALF * K * 2;
    const size_t tstep = 2 * hstep;
    const unsigned ldsw = (unsigned)wid * 1024u;
    const int aoff = lds_byte(wr * 64 + fr, fq * 8), boff = lds_byte(wc * 32 + fr, fq * 8);
#define PG8_SA(b, h) (((b) * 2 + (h)) * HTB)
#define PG8_SB(b, h) ((4 + (b) * 2 + (h)) * HTB)
#define PG8_STAGE(bufoff, gbase, voff) do { _Pragma("unroll") for (int _i = 0; _i < 2; ++_i) \
        __builtin_amdgcn_global_load_lds((const unsigned*)((const char*)(gbase) + (voff)[_i]), (PG8_LAS unsigned*)(lds + (bufoff) + ldsw + _i * 8192), 16, 0, 0); } while (0)
#define PG8_LDA(dst, b, h) do { _Pragma("unroll") for (int m = 0; m < 4; ++m) _Pragma("unroll") for (int k = 0; k < 2; ++k) dst[m][k] = *(const PG8_LAS bf16x8*)(lds + PG8_SA(b, h) + aoff + m * 2048 + k * 1024); } while (0)
#define PG8_LDB(dst, b, h) do { _Pragma("unroll") for (int n = 0; n < 2; ++n) _Pragma("unroll") for (int k = 0; k < 2; ++k) dst[n][k] = *(const PG8_LAS bf16x8*)(lds + PG8_SB(b, h) + boff + n * 2048 + k * 1024); } while (0)
#define PG8_MMA(ai, bj, At, Bt) do { __builtin_amdgcn_s_setprio(1); _Pragma("unroll") for (int m = 0; m < 4; ++m) _Pragma("unroll") for (int n = 0; n < 2; ++n) _Pragma("unroll") for (int k = 0; k < 2; ++k) \
        acc[ai][bj][m][n] = __builtin_amdgcn_mfma_f32_16x16x32_bf16(Bt[n][k], At[m][k], acc[ai][bj][m][n], 0, 0, 0); __builtin_amdgcn_s_setprio(0); } while (0)
#define PG8_WAIT_V(n) asm volatile("s_waitcnt vmcnt(" #n ")" ::: "memory")
#define PG8_WAIT_L(n) asm volatile("s_waitcnt lgkmcnt(" #n ")" ::: "memory")
#define PG8_BAR __builtin_amdgcn_s_barrier()
#define PG8_SCHED __builtin_amdgcn_sched_barrier(0)
    Unit cur, nxt; int ui = 0;
    if (!S.next(0, cur)) return;
    f32x4 acc[2][2][4][2];
#pragma unroll
    for (int a = 0; a < 2; ++a)
#pragma unroll
        for (int b = 0; b < 2; ++b)
#pragma unroll
            for (int m = 0; m < 4; ++m)
#pragma unroll
                for (int n = 0; n < 2; ++n) acc[a][b][m][n] = (f32x4){0.f, 0.f, 0.f, 0.f};
    bf16x8 At[4][2], B0[2][2], B1[2][2];
    const char* cA = (const char*)g.A + (size_t)cur.pm * tstep; const char* cB = (const char*)g.Bt + (size_t)cur.pn * tstep;
    S.a_ready(cur);
    if constexpr (SP2) {
        PG8_STAGE(PG8_SB(0, 0), cB, voffB); PG8_STAGE(PG8_SB(0, 1), cB + hstep, voffB); PG8_STAGE(PG8_SA(0, 0), cA, voffA); PG8_STAGE(PG8_SA(0, 1), cA + hstep, voffA);
        if (wr == 1) PG8_BAR;
        PG8_WAIT_V(2); PG8_BAR;
        PG8_STAGE(PG8_SB(1, 0), cB + kstep, voffB); PG8_STAGE(PG8_SA(1, 0), cA + kstep, voffA); PG8_STAGE(PG8_SB(1, 1), cB + hstep + kstep, voffB);
        PG8_WAIT_V(6); PG8_BAR;
    } else {
        PG8_STAGE(PG8_SB(0, 0), cB, voffB); PG8_STAGE(PG8_SA(0, 0), cA, voffA); PG8_STAGE(PG8_SB(0, 1), cB + hstep, voffB); PG8_STAGE(PG8_SA(0, 1), cA + hstep, voffA);
        if (wr == 1) PG8_BAR;
        PG8_WAIT_V(4); PG8_BAR;
        PG8_STAGE(PG8_SB(1, 0), cB + kstep, voffB); PG8_STAGE(PG8_SA(1, 0), cA + kstep, voffA); PG8_STAGE(PG8_SB(1, 1), cB + hstep + kstep, voffB);
        PG8_WAIT_V(6); PG8_BAR;
    }
    for (;;) {
        const bool has_next = S.next(ui + 1, nxt);
        const char* nA = has_next ? (const char*)g.A + (size_t)nxt.pm * tstep : cA; const char* nB = has_next ? (const char*)g.Bt + (size_t)nxt.pn * tstep : cB;
        for (int t = 0; t < nt; t += 2) {
            if constexpr (Epi::HAS_MID) { if (t == nt / 2) E.mid(acc, cur, wr, wc, fr, fq); }
            const bool last = (t == nt - 2);
            const char* a1 = cA + (size_t)(t + 1) * kstep;
            const char* a2 = last ? nA : cA + (size_t)(t + 2) * kstep; const char* b2 = last ? nB : cB + (size_t)(t + 2) * kstep;
            const char* a3 = a2 + kstep; const char* b3 = b2 + kstep;
            if (last && has_next) S.a_ready(nxt);
            if constexpr (SP2) {
            PG8_LDB(B0, 0, 0); PG8_LDB(B1, 0, 1); PG8_SCHED; PG8_LDA(At, 0, 0); PG8_STAGE(PG8_SA(1, 1), a1 + hstep, voffA);
            PG8_WAIT_V(8); PG8_WAIT_L(0); PG8_BAR; PG8_MMA(0, 0, At, B0); PG8_MMA(0, 1, At, B1); PG8_BAR; PG8_SCHED;
            PG8_LDA(At, 0, 1); PG8_STAGE(PG8_SB(0, 0), b2, voffB); PG8_STAGE(PG8_SB(0, 1), b2 + hstep, voffB); PG8_STAGE(PG8_SA(0, 0), a2, voffA);
            PG8_WAIT_V(8); PG8_WAIT_L(0); PG8_BAR; PG8_MMA(1, 0, At, B0); PG8_MMA(1, 1, At, B1); PG8_BAR; PG8_SCHED;
            PG8_LDB(B0, 1, 0); PG8_LDB(B1, 1, 1); PG8_SCHED; PG8_LDA(At, 1, 0); PG8_STAGE(PG8_SA(0, 1), a2 + hstep, voffA);
            PG8_WAIT_V(8); PG8_WAIT_L(0); PG8_BAR; PG8_MMA(0, 0, At, B0); PG8_MMA(0, 1, At, B1); PG8_BAR; PG8_SCHED;
            PG8_LDA(At, 1, 1); PG8_STAGE(PG8_SB(1, 0), b3, voffB); PG8_STAGE(PG8_SB(1, 1), b3 + hstep, voffB); PG8_STAGE(PG8_SA(1, 0), a3, voffA);
            PG8_WAIT_V(8); PG8_WAIT_L(0); PG8_BAR; PG8_MMA(1, 0, At, B0); PG8_MMA(1, 1, At, B1); PG8_BAR; PG8_SCHED;
            } else {
            PG8_LDB(B0, 0, 0); PG8_SCHED; PG8_LDA(At, 0, 0); PG8_STAGE(PG8_SA(1, 1), a1 + hstep, voffA);
            PG8_WAIT_L(8); PG8_BAR; PG8_WAIT_L(0); PG8_MMA(0, 0, At, B0); PG8_BAR; PG8_SCHED;
            PG8_LDB(B1, 0, 1); PG8_STAGE(PG8_SB(0, 0), b2, voffB);
            PG8_BAR; PG8_WAIT_L(0); PG8_MMA(0, 1, At, B1); PG8_BAR;
            PG8_LDA(At, 0, 1); PG8_STAGE(PG8_SA(0, 0), a2, voffA);
            PG8_BAR; PG8_WAIT_L(0); PG8_MMA(1, 0, At, B0); PG8_BAR; PG8_SCHED;
            PG8_STAGE(PG8_SB(0, 1), b2 + hstep, voffB);
            PG8_WAIT_V(6); PG8_BAR; PG8_MMA(1, 1, At, B1); PG8_BAR;
            PG8_LDB(B0, 1, 0); PG8_SCHED; PG8_LDA(At, 1, 0); PG8_STAGE(PG8_SA(0, 1), a2 + hstep, voffA);
            PG8_WAIT_L(8); PG8_BAR; PG8_WAIT_L(0); PG8_MMA(0, 0, At, B0); PG8_BAR; PG8_SCHED;
            PG8_LDB(B1, 1, 1); PG8_STAGE(PG8_SB(1, 0), b3, voffB);
            PG8_BAR; PG8_WAIT_L(0); PG8_MMA(0, 1, At, B1); PG8_BAR;
            PG8_LDA(At, 1, 1); PG8_STAGE(PG8_SA(1, 0), a3, voffA);
            PG8_BAR; PG8_WAIT_L(0); PG8_MMA(1, 0, At, B0); PG8_BAR; PG8_SCHED;
            PG8_STAGE(PG8_SB(1, 1), b3 + hstep, voffB);
            PG8_WAIT_V(6); PG8_BAR; PG8_MMA(1, 1, At, B1); PG8_BAR;
            }
        }
        if constexpr (ALIGN_EPI) { if (wr == 0) PG8_BAR; }
        if constexpr (!Epi::AFTER_DRAIN) { E(acc, cur, wr, wc, fr, fq); S.done(cur); }
        if (!has_next) break;
#pragma unroll
        for (int a = 0; a < 2; ++a)
#pragma unroll
            for (int b = 0; b < 2; ++b)
#pragma unroll
                for (int m = 0; m < 4; ++m)
#pragma unroll
                    for (int n = 0; n < 2; ++n) acc[a][b][m][n] = (f32x4){0.f, 0.f, 0.f, 0.f};
        cur = nxt; cA = nA; cB = nB; ++ui;
        if constexpr (ALIGN_EPI) { if (wr == 1) PG8_BAR; }
    }
    PG8_WAIT_V(0);
    if constexpr (!ALIGN_EPI) { if (wr == 0) PG8_BAR; }
    PG8_BAR;
    if constexpr (Epi::AFTER_DRAIN) { E.fused(acc, cur, wr, wc, fr, fq, lds, wid, lane); S.done(cur); }
#undef PG8_SA
#undef PG8_SB
#undef PG8_STAGE
#undef PG8_LDA
#undef PG8_LDB
#undef PG8_MMA
#undef PG8_WAIT_V
#undef PG8_WAIT_L
#undef PG8_BAR
#undef PG8_SCHED
}
}

#define LAS __attribute__((address_space(3)))
typedef unsigned short bf16;
typedef unsigned v4u __attribute__((ext_vector_type(4)));
typedef unsigned v2u __attribute__((ext_vector_type(2)));
typedef float f32x4 __attribute__((ext_vector_type(4)));
typedef float f32x16 __attribute__((ext_vector_type(16)));
typedef short bf16x8 __attribute__((ext_vector_type(8)));
typedef float f32x2_t __attribute__((ext_vector_type(2)));
typedef __bf16 bf16x2_t __attribute__((ext_vector_type(2)));
#define LDS_WAIT() asm volatile("s_waitcnt lgkmcnt(0)" ::: "memory")
constexpr int LDS_BYTES = 147456;
constexpr int NWAVES = 8;

struct Params { const float* in[20]; float* out; unsigned char* ws; };

__device__ __forceinline__ unsigned pk2(float lo, float hi) { f32x2_t v = {lo, hi}; bf16x2_t b = __builtin_convertvector(v, bf16x2_t); return __builtin_bit_cast(unsigned, b); }
__device__ __forceinline__ float bflo(unsigned u) { return __uint_as_float(u << 16); }
__device__ __forceinline__ float bfhi(unsigned u) { return __uint_as_float(u & 0xffff0000u); }
__device__ __forceinline__ float ex2(float x) { return __builtin_amdgcn_exp2f(x); }
__device__ __forceinline__ float lg2(float x) { return __builtin_amdgcn_logf(x); }
__device__ __forceinline__ float rcp(float x) { return __builtin_amdgcn_rcpf(x); }
__device__ __forceinline__ float sigm(float x) { return rcp(1.0f + ex2(-LOG2E * x)); }
__device__ __forceinline__ float wave_sum(float v) {
#pragma unroll
    for (int o = 1; o < 64; o <<= 1) v += __shfl_xor(v, o);
    return v;
}

__device__ __forceinline__ void transpose_item(const float* W, int ldw, int K, int ncols, bf16* WT, int row_off, LAS float* scr, int item, int lane) {
    const int nblk = ncols / 32, kb = item / nblk, nb = item % nblk, k0 = 64 * kb, n0 = 32 * nb;
    float tv[32];
#pragma unroll
    for (int i = 0; i < 32; ++i) { const int kk = 2 * i + (lane >> 5); tv[i] = W[(size_t)(k0 + kk) * ldw + n0 + (lane & 31)]; }
#pragma unroll
    for (int i = 0; i < 32; ++i) { const int kk = 2 * i + (lane >> 5); scr[kk * 33 + (lane & 31)] = tv[i]; }
    LDS_WAIT();
    const int c = lane & 7;
#pragma unroll
    for (int j = 0; j < 4; ++j) { const int n = (lane >> 3) + 8 * j; const LAS float* s = scr + (8 * c) * 33 + n;
        v4u o; o.x = pk2(s[0 * 33], s[1 * 33]); o.y = pk2(s[2 * 33], s[3 * 33]); o.z = pk2(s[4 * 33], s[5 * 33]); o.w = pk2(s[6 * 33], s[7 * 33]);
        *(v4u*)(WT + (size_t)(row_off + n0 + n) * K + k0 + 8 * c) = o; }
    LDS_WAIT();
}

__device__ __forceinline__ void transpose_item_kp(const float* W, int ldw, int K, int ncols, bf16* WT, int dpitch, int koff, LAS float* scr, int item, int lane) {
    const int nblk = ncols / 32, kb = item / nblk, nb = item % nblk, k0 = 64 * kb, n0 = 32 * nb;
    float tv[32];
#pragma unroll
    for (int i = 0; i < 32; ++i) { const int kk = 2 * i + (lane >> 5); tv[i] = W[(size_t)(k0 + kk) * ldw + n0 + (lane & 31)]; }
#pragma unroll
    for (int i = 0; i < 32; ++i) { const int kk = 2 * i + (lane >> 5); scr[kk * 33 + (lane & 31)] = tv[i]; }
    LDS_WAIT();
    const int c = lane & 7;
#pragma unroll
    for (int j = 0; j < 4; ++j) { const int n = (lane >> 3) + 8 * j; const LAS float* s = scr + (8 * c) * 33 + n;
        v4u o; o.x = pk2(s[0 * 33], s[1 * 33]); o.y = pk2(s[2 * 33], s[3 * 33]); o.z = pk2(s[4 * 33], s[5 * 33]); o.w = pk2(s[6 * 33], s[7 * 33]);
        *(v4u*)(WT + (size_t)(n0 + n) * dpitch + koff + k0 + 8 * c) = o; }
    LDS_WAIT();
}

__device__ __forceinline__ void phase0(const Params& p, LAS unsigned char* lds, int tid, int lane, int wave) {
    unsigned char* ws = p.ws;
    { float* rowss = (float*)(ws + WS_ROWSS); for (int e = blockIdx.x * 512 + tid; e < M; e += gridDim.x * 512) rowss[e] = 0.f; }
    LAS float* scr = (LAS float*)(lds + wave * 16384);
    const int gw = blockIdx.x * NWAVES + wave, NGW = gridDim.x * NWAVES;
    const float* w_in = p.in[7];
    bf16* Win_t = (bf16*)(ws + WS_WIN);
    constexpr int I0 = 16 * 40, I1 = 16 * 48, I2 = 16 * 32, I3 = 16 * 32, I4 = 8 * 32, I5 = 8 * 32, I6 = 16 * 32, I7 = 16 * 128, I8 = 64 * 32, I9 = 32 * 2, I10 = 32 * 2;
    constexpr int NITEMS = I0 + I1 + I2 + I3 + I4 + I5 + I6 + I7 + I8 + I9 + I10;
    for (int it = gw; it < NITEMS; it += NGW) {
        int r = it;
        if (r < I0) { transpose_item(w_in, 4888, DM, 1280, Win_t, 0, scr, r, lane); continue; } r -= I0;
        if (r < I1) { transpose_item(w_in + 1304, 4888, DM, 1536, Win_t, 1280, scr, r, lane); continue; } r -= I1;
        if (r < I2) { transpose_item(w_in + 2840, 4888, DM, 1024, Win_t, 2816, scr, r, lane); continue; } r -= I2;
        if (r < I3) { transpose_item(w_in + 3864, 4888, DM, 1024, Win_t, 3840, scr, r, lane); continue; } r -= I3;
        if (r < I4) { transpose_item_kp(p.in[15], DM, 512, DM, (bf16*)(ws + WS_WUPA), DM, 0, scr, r, lane); continue; } r -= I4;
        if (r < I5) { transpose_item_kp(p.in[16], DM, 512, DM, (bf16*)(ws + WS_WUPA), DM, 512, scr, r, lane); continue; } r -= I5;
        if (r < I6) { transpose_item(p.in[17], DM, DM, DM, (bf16*)(ws + WS_WOUT), 0, scr, r, lane); continue; } r -= I6;
        if (r < I7) { transpose_item(p.in[18], FF, DM, FF, (bf16*)(ws + WS_W1), 0, scr, r, lane); continue; } r -= I7;
        if (r < I8) { transpose_item(p.in[19], DM, FF, DM, (bf16*)(ws + WS_W2), 0, scr, r, lane); continue; } r -= I8;
        if (r < I9) { transpose_item(p.in[9], 64, 2048, 64, (bf16*)(ws + WS_CW1K), 0, scr, r, lane); continue; } r -= I9;
        transpose_item(p.in[11], 64, 2048, 64, (bf16*)(ws + WS_CW1V), 0, scr, r, lane);
    }
    __syncthreads();
    LAS float* sc = (LAS float*)lds;
    LAS float* red = (LAS float*)(lds + 65536);
    float* mod = (float*)(ws + WS_MOD);
    for (int it = blockIdx.x; it < 247; it += gridDim.x) {
        if (it < 192) {
            const float* c = p.in[1]; const float* ada_w = p.in[3]; const float* ada_b = p.in[4];
            for (int e = tid; e < 16384; e += 512) { const float v = c[e]; sc[e] = v * sigm(v); }
            __syncthreads();
            const int colj = tid & 31, kg = tid >> 5, j0 = it * 32;
            float acc[16];
#pragma unroll
            for (int b = 0; b < 16; ++b) acc[b] = 0.f;
            for (int k8 = kg * 64; k8 < kg * 64 + 64; k8 += 8) {
                float w[8];
#pragma unroll
                for (int u = 0; u < 8; ++u) w[u] = ada_w[(size_t)(k8 + u) * 6144 + j0 + colj];
#pragma unroll
                for (int u = 0; u < 8; ++u)
#pragma unroll
                    for (int b = 0; b < 16; ++b) acc[b] += sc[b * 1024 + k8 + u] * w[u];
            }
#pragma unroll
            for (int b = 0; b < 16; ++b) red[(kg * 16 + b) * 32 + colj] = acc[b];
            __syncthreads();
            { const int b = tid >> 5, cj = tid & 31; float s = ada_b[j0 + cj];
#pragma unroll
              for (int k2 = 0; k2 < 16; ++k2) s += red[(k2 * 16 + b) * 32 + cj];
              mod[b * 6144 + j0 + cj] = s; }
            __syncthreads();
        } else if (it < 194) {
            const int kv = it - 192; const float* w1 = kv ? p.in[11] : p.in[9]; const float* pos = p.in[8];
            const int colj = tid & 63, kg = tid >> 6; float a = 0.f;
            for (int k16 = kg * 256; k16 < kg * 256 + 256; k16 += 16) {
                float w[16], pv_[16];
#pragma unroll
                for (int u = 0; u < 16; ++u) { w[u] = w1[(k16 + u) * 64 + colj]; pv_[u] = pos[k16 + u]; }
#pragma unroll
                for (int u = 0; u < 16; ++u) a += pv_[u] * w[u];
            }
            red[kg * 64 + colj] = a;
            __syncthreads();
            if (tid < 64) { float s = 0.f;
#pragma unroll
                for (int k2 = 0; k2 < 8; ++k2) s += red[k2 * 64 + tid];
                ((float*)(ws + WS_PW1))[kv * 64 + tid] = s; }
            __syncthreads();
        } else if (it < 218) {
            const int r = it - 194;
            for (int k = tid; k < 1024; k += 512) Win_t[(size_t)(4864 + r) * 1024 + k] = (bf16)(pk2(w_in[(size_t)k * 4888 + 1280 + r], 0.f) & 0xffffu);
        } else {
            v4u* zp = (v4u*)(Win_t + (size_t)(4888 + 8 * (it - 218)) * 1024);
            for (int e = tid; e < 8 * 1024 / 8; e += 512) zp[e] = (v4u){0u, 0u, 0u, 0u};
        }
    }
}

__device__ __forceinline__ void norm_rows(const float* src, const float* gain, const float* mod, int shift_off, int scale_off, bf16* dst, int lane, int wave) {
    const int gw = blockIdx.x * NWAVES + wave, NGW = gridDim.x * NWAVES;
    const int rpw = (M + NGW - 1) / NGW;
    const int m0 = gw * rpw, m1 = (m0 + rpw < M) ? m0 + rpw : M;
    if (m0 >= M) return;
    f32x4 gam[4], sh[4];
    int bcur = -1;
    f32x4 v[4], nx[4];
    { const f32x4* xr = (const f32x4*)(src + (size_t)m0 * DM) + lane;
#pragma unroll
      for (int j = 0; j < 4; ++j) nx[j] = xr[64 * j]; }
    for (int m = m0; m < m1; ++m) {
        const int b = m >> 12;
        if (b != bcur) { bcur = b;
#pragma unroll
            for (int j = 0; j < 4; ++j) { const int col = 4 * (lane + 64 * j);
                const f32x4 g = *(const f32x4*)(gain + col), sc = *(const f32x4*)(mod + b * 6144 + scale_off + col); sh[j] = *(const f32x4*)(mod + b * 6144 + shift_off + col);
                gam[j] = g * (sc + 1.0f); } }
#pragma unroll
        for (int j = 0; j < 4; ++j) v[j] = nx[j];
        if (m + 1 < m1) { const f32x4* xr = (const f32x4*)(src + (size_t)(m + 1) * DM) + lane;
#pragma unroll
            for (int j = 0; j < 4; ++j) nx[j] = xr[64 * j]; }
        float ss = 0.f;
#pragma unroll
        for (int j = 0; j < 4; ++j) ss += (v[j].x * v[j].x + v[j].y * v[j].y) + (v[j].z * v[j].z + v[j].w * v[j].w);
        const float rstd = rsqrtf(wave_sum(ss) * (1.0f / DM) + 1e-6f);
#pragma unroll
        for (int j = 0; j < 4; ++j) { const int col = 4 * (lane + 64 * j);
            const f32x4 u = (v[j] * rstd) * gam[j] + sh[j];
            v2u w; w.x = pk2(u.x, u.y); w.y = pk2(u.z, u.w);
            *(v2u*)(dst + (size_t)m * DM + col) = w; }
    }
}

__device__ __forceinline__ void phase3(const Params& p, LAS unsigned char* lds, int tid, int lane, int wave, bool do_norm) {
    unsigned char* ws = p.ws;
    bf16* Z = (bf16*)(ws + WS_Z);
    const int gw = blockIdx.x * NWAVES + wave, NGW = gridDim.x * NWAVES;
    {
        LAS float* hid = (LAS float*)(lds + wave * 4352);
        const int row = lane & 15, quad = lane >> 4;
        for (int task = (NGW - 1 - gw); task < 1024; task += NGW) {
            const int kv = task & 1, cg16 = (task >> 1) & 15, hkv = (task >> 5) & 1, b = task >> 6;
            const int c0 = cg16 * 16;
            const bf16* w1t = (const bf16*)(ws + (kv ? WS_CW1V : WS_CW1K));
            const float* pw1 = (const float*)(ws + WS_PW1) + kv * 64;
            const float* w2 = kv ? p.in[12] : p.in[10];
            const int zc = (kv ? ZVC : ZKC) + hkv * 64;
            int t0 = 16 * (c0 + row);
            f32x4 acc[4];
#pragma unroll
            for (int nt = 0; nt < 4; ++nt) acc[nt] = (f32x4){0.f, 0.f, 0.f, 0.f};
#pragma unroll 8
            for (int s = 0; s < 64; ++s) {
                int tk = t0 + (s >> 1); tk = tk < S ? tk : S - 1;
                const bf16x8 a = *(const bf16x8*)(Z + ((size_t)b * S + tk) * ZW + zc + (s & 1) * 32 + quad * 8);
#pragma unroll
                for (int nt = 0; nt < 4; ++nt) { const bf16x8 bb = *(const bf16x8*)(w1t + (size_t)(nt * 16 + row) * 2048 + s * 32 + quad * 8);
                    acc[nt] = __builtin_amdgcn_mfma_f32_16x16x32_bf16(a, bb, acc[nt], 0, 0, 0); }
            }
#pragma unroll
            for (int nt = 0; nt < 4; ++nt) { const float pb = pw1[nt * 16 + row];
#pragma unroll
                for (int j = 0; j < 4; ++j) { const float x = acc[nt][j] + pb; hid[(quad * 4 + j) * 68 + nt * 16 + row] = x * sigm(x); } }
            LDS_WAIT();
            float o[16];
#pragma unroll
            for (int r = 0; r < 16; ++r) o[r] = 0.f;
            for (int k = 0; k < 64; k += 4) {
                const float wa = w2[(k + 0) * 64 + lane], wb = w2[(k + 1) * 64 + lane], wc_ = w2[(k + 2) * 64 + lane], wd = w2[(k + 3) * 64 + lane];
#pragma unroll
                for (int r = 0; r < 16; ++r) { const f32x4 h = *(const LAS f32x4*)(hid + r * 68 + k); o[r] += h.x * wa + h.y * wb + h.z * wc_ + h.w * wd; }
            }
            LDS_WAIT();
            if (kv == 0) {
                const float gn = p.in[14][lane];
                bf16* KC = (bf16*)(ws + WS_KC) + ((size_t)(b * 2 + hkv) * 256 + c0) * 64 + lane;
#pragma unroll
                for (int r = 0; r < 16; ++r) { const float ss = wave_sum(o[r] * o[r]); const float rstd = rsqrtf(ss * (1.0f / 64.0f) + 1e-6f);
                    const float v = (c0 + r < 255) ? o[r] * rstd * gn : 0.f; KC[r * 64] = (bf16)(pk2(v, 0.f) & 0xffffu); }
            } else {
                bf16* VCT = (bf16*)(ws + WS_VCT) + ((size_t)(b * 2 + hkv) * 64 + lane) * 256 + c0;
                if (c0 + 15 >= 255) o[15] = 0.f;
                v4u w0, w1;
                w0.x = pk2(o[0], o[1]); w0.y = pk2(o[2], o[3]); w0.z = pk2(o[8], o[9]); w0.w = pk2(o[10], o[11]);
                w1.x = pk2(o[4], o[5]); w1.y = pk2(o[6], o[7]); w1.z = pk2(o[12], o[13]); w1.w = pk2(o[14], o[15]);
                *(v4u*)VCT = w0; *(v4u*)(VCT + 8) = w1;
            }
        }
    }
    __syncthreads();
    if (do_norm) {
        const float* qg = p.in[13]; const float* kg = p.in[14];
        const int sub = lane & 7;
        const long total = (long)M * 12;
        if (gw < NGW / 2)
        for (long base = (long)gw * 32; base < total; base += (long)(NGW / 2) * 32) {
            v4u raw[4]; v4u* ptr[4]; const float* gnp[4]; float extra[4];
#pragma unroll
            for (int u = 0; u < 4; ++u) {
                const long vi = base + u * 8 + (lane >> 3);
                const int tokn = (int)(vi / 12), which = (int)(vi - (long)tokn * 12);
                int col; extra[u] = 1.0f;
                if (which < 8) { col = ZQ + which * 64; gnp[u] = qg; extra[u] = 0.125f * LOG2E; }
                else if (which < 10) { col = ZKS + (which - 8) * 64; gnp[u] = kg + 64; }
                else { col = ZKW + (which - 10) * 64; gnp[u] = kg + 128; }
                ptr[u] = (v4u*)(Z + (size_t)tokn * ZW + col + sub * 8);
                raw[u] = *ptr[u];
            }
#pragma unroll
            for (int u = 0; u < 4; ++u) {
                const v4u rw = raw[u];
                float f[8] = {bflo(rw.x), bfhi(rw.x), bflo(rw.y), bfhi(rw.y), bflo(rw.z), bfhi(rw.z), bflo(rw.w), bfhi(rw.w)};
                float ss = 0.f;
#pragma unroll
                for (int e2 = 0; e2 < 8; ++e2) ss += f[e2] * f[e2];
                ss += __shfl_xor(ss, 1); ss += __shfl_xor(ss, 2); ss += __shfl_xor(ss, 4);
                const float rstd = rsqrtf(ss * (1.0f / 64.0f) + 1e-6f) * extra[u];
                const f32x4 g0 = *(const f32x4*)(gnp[u] + sub * 8), g1 = *(const f32x4*)(gnp[u] + sub * 8 + 4);
                v4u o; o.x = pk2(f[0] * rstd * g0.x, f[1] * rstd * g0.y); o.y = pk2(f[2] * rstd * g0.z, f[3] * rstd * g0.w);
                o.z = pk2(f[4] * rstd * g1.x, f[5] * rstd * g1.y); o.w = pk2(f[6] * rstd * g1.z, f[7] * rstd * g1.w);
                *ptr[u] = o;
            }
        }
    }
    __syncthreads();
    { LAS float* shl = (LAS float*)lds; const float* mod = (const float*)(ws + WS_MOD); const bf16* W1t = (const bf16*)(ws + WS_W1); float* sw = (float*)(ws + WS_SW);
      for (int e = tid; e < 16384; e += 512) shl[e] = mod[(e >> 10) * 6144 + 3072 + (e & 1023)];
      __syncthreads();
      for (int colx = gw; colx < FF; colx += NGW) {
          const v4u wa = *(const v4u*)(W1t + (size_t)colx * DM + lane * 16), wb = *(const v4u*)(W1t + (size_t)colx * DM + lane * 16 + 8);
          const float wv[16] = {bflo(wa.x), bfhi(wa.x), bflo(wa.y), bfhi(wa.y), bflo(wa.z), bfhi(wa.z), bflo(wa.w), bfhi(wa.w), bflo(wb.x), bfhi(wb.x), bflo(wb.y), bfhi(wb.y), bflo(wb.z), bfhi(wb.z), bflo(wb.w), bfhi(wb.w)};
          float res = 0.f;
#pragma unroll 1
          for (int bb = 0; bb < 16; ++bb) { float a = 0.f;
#pragma unroll
              for (int e4 = 0; e4 < 4; ++e4) { const f32x4 s4 = *(const LAS f32x4*)(shl + bb * 1024 + lane * 16 + e4 * 4); a += s4.x * wv[4 * e4] + s4.y * wv[4 * e4 + 1] + s4.z * wv[4 * e4 + 2] + s4.w * wv[4 * e4 + 3]; }
              a = wave_sum(a); if (lane == bb) res = a; }
          if (lane < 16) sw[(size_t)lane * FF + colx] = res;
      } }
}

constexpr int NSTG = 4, STG_BYTES = 16384, LUT_OFF = 65536, ACC_OFF = 69632, MISC4_OFF = 135168, LUT2_OFF = 137728;
#define MFMA32(a, b, c) __builtin_amdgcn_mfma_f32_32x32x16_bf16((a), (b), (c), 0, 0, 0)
#define KKOF(hf, r) (32 * (hf) + ((r) & 3) + 8 * ((r) >> 2))
constexpr float NEGBIG = -1.0e30f;

__device__ __forceinline__ void glds16(const void* gsrc, unsigned lds_dst) {
    unsigned keep;
    asm volatile("s_mov_b32 %0, m0\n\ts_mov_b32 m0, %2\n\ts_nop 0\n\tglobal_load_lds_dwordx4 %1, off\n\ts_mov_b32 m0, %0" : "=&s"(keep) : "v"(gsrc), "s"(lds_dst) : "memory");
}
#define WAITV_BAR(N) asm volatile("s_waitcnt vmcnt(" #N ")\n\ts_barrier" ::: "memory")
#define RING_WAIT(ahead) do { if ((ahead) >= 2) WAITV_BAR(4); else if ((ahead) == 1) WAITV_BAR(2); else WAITV_BAR(0); } while (0)
#define RING_WAIT4(ahead) do { if ((ahead) >= 2) WAITV_BAR(8); else if ((ahead) == 1) WAITV_BAR(4); else WAITV_BAR(0); } while (0)
#define RING_DRAIN() asm volatile("s_waitcnt vmcnt(0)" ::: "memory")

struct Ring {
    int r8, c8; unsigned base;
    __device__ __forceinline__ void init(LAS unsigned char* lds, int lane, int wave) { r8 = 8 * wave + (lane >> 3); c8 = (lane & 7) ^ ((lane >> 3) & 7); base = (unsigned)(uintptr_t)lds + (unsigned)wave * 1024u; }
    __device__ __forceinline__ void issue4(const bf16* k, const bf16* v, size_t pitch, int stage) const {
        const size_t o = (size_t)r8 * pitch + c8 * 8; const unsigned d = base + (unsigned)stage * (2u * STG_BYTES);
        glds16(k + o, (unsigned)__builtin_amdgcn_readfirstlane(d));
        glds16(v + o, (unsigned)__builtin_amdgcn_readfirstlane(d + 8192u));
        glds16(k + o + 64, (unsigned)__builtin_amdgcn_readfirstlane(d + 16384u));
        glds16(v + o + 64, (unsigned)__builtin_amdgcn_readfirstlane(d + 24576u));
    }
    __device__ __forceinline__ void issue(const bf16* k, size_t kpitch, const bf16* vt, size_t vpitch, int stage) const {
        glds16(k + (size_t)r8 * kpitch + c8 * 8, (unsigned)__builtin_amdgcn_readfirstlane(base + (unsigned)stage * STG_BYTES));
        glds16(vt + (size_t)r8 * vpitch + c8 * 8, (unsigned)__builtin_amdgcn_readfirstlane(base + (unsigned)stage * STG_BYTES + 8192u));
    }
};

__device__ __forceinline__ void qk_tile(const LAS unsigned char* kb, const bf16x8 (&qf)[4], int col, int hi, f32x16& s0, f32x16& s1, float cinit) {
    const LAS unsigned char* k0 = kb + col * 128; const int k7 = col & 7;
    bf16x8 a0[4], a1[4];
#pragma unroll
    for (int d0 = 0; d0 < 4; ++d0) { const int off = ((2 * d0 + hi) ^ k7) << 4; a0[d0] = *(const LAS bf16x8*)(k0 + off); a1[d0] = *(const LAS bf16x8*)(k0 + 32 * 128 + off); }
    asm volatile("" ::: "memory");
    f32x16 c;
#pragma unroll
    for (int r = 0; r < 16; ++r) c[r] = cinit;
    s0 = MFMA32(a0[0], qf[0], c); s1 = MFMA32(a1[0], qf[0], c);
#pragma unroll
    for (int d0 = 1; d0 < 4; ++d0) { s0 = MFMA32(a0[d0], qf[d0], s0); s1 = MFMA32(a1[d0], qf[d0], s1); }
}
__device__ __forceinline__ void qk_half_c(const LAS unsigned char* kb, const bf16x8 (&qf)[4], int col, int hi, int hf, f32x16& s, const f32x16& c) {
    const LAS unsigned char* k0 = kb + (32 * hf + col) * 128; const int k7 = col & 7;
    bf16x8 a[4];
#pragma unroll
    for (int d0 = 0; d0 < 4; ++d0) a[d0] = *(const LAS bf16x8*)(k0 + (((2 * d0 + hi) ^ k7) << 4));
    asm volatile("" ::: "memory");
    s = MFMA32(a[0], qf[0], c);
#pragma unroll
    for (int d0 = 1; d0 < 4; ++d0) s = MFMA32(a[d0], qf[d0], s);
}
__device__ __forceinline__ void qk_half(const LAS unsigned char* kb, const bf16x8 (&qf)[4], int col, int hi, int hf, f32x16& s, float cinit) {
    f32x16 c;
#pragma unroll
    for (int r = 0; r < 16; ++r) c[r] = cinit;
    qk_half_c(kb, qf, col, hi, hf, s, c);
}
__device__ __forceinline__ void pv_half(const LAS unsigned char* vb, const unsigned (&pw)[8], int col, int hi, int hf, f32x16& o0, f32x16& o1, f32x16& os, bf16x8 ones) {
    const LAS unsigned char* v0 = vb + col * 128; const int k7 = col & 7;
    bf16x8 a[2], bq[2];
#pragma unroll
    for (int s2 = 0; s2 < 2; ++s2) { const int e = ((2 * (2 * hf + s2) + hi) ^ k7) << 4; a[s2] = *(const LAS bf16x8*)(v0 + e); bq[s2] = *(const LAS bf16x8*)(v0 + 32 * 128 + e); }
    asm volatile("" ::: "memory");
#pragma unroll
    for (int s2 = 0; s2 < 2; ++s2) {
        const v4u pu = {pw[4 * s2], pw[4 * s2 + 1], pw[4 * s2 + 2], pw[4 * s2 + 3]};
        const bf16x8 pf = __builtin_bit_cast(bf16x8, pu);
        o0 = MFMA32(a[s2], pf, o0);
        o1 = MFMA32(bq[s2], pf, o1);
        os = MFMA32(ones, pf, os);
    }
}
__device__ __forceinline__ void pv_tile(const LAS unsigned char* vb, const unsigned (&pw)[16], int col, int hi, f32x16& o0, f32x16& o1) {
    const LAS unsigned char* v0 = vb + col * 128; const int k7 = col & 7;
#pragma unroll
    for (int sl = 0; sl < 4; ++sl) {
        const v4u pu = {pw[4 * sl], pw[4 * sl + 1], pw[4 * sl + 2], pw[4 * sl + 3]};
        const bf16x8 pf = __builtin_bit_cast(bf16x8, pu);
        const int e = ((2 * sl + hi) ^ k7) << 4;
        const bf16x8 a = *(const LAS bf16x8*)(v0 + e), bq = *(const LAS bf16x8*)(v0 + 32 * 128 + e);
        o0 = MFMA32(a, pf, o0);
        o1 = MFMA32(bq, pf, o1);
    }
}
typedef short v4i16_t __attribute__((ext_vector_type(4)));
__device__ __forceinline__ v2u vtr8(const LAS unsigned char* p) { return __builtin_bit_cast(v2u, __builtin_amdgcn_ds_read_tr16_b64_v4i16((LAS v4i16_t*)p)); }
struct TrAddr { int base0, ch0, ch1; };
__device__ __forceinline__ TrAddr tr_addr(int lane) {
    const int h = lane >> 5, blk = (lane >> 4) & 1, q = (lane & 15) >> 2, pp = lane & 3, r7 = 4 * h + q;
    TrAddr a; a.base0 = r7 * 128 + 8 * (pp & 1); a.ch0 = ((2 * blk + (pp >> 1)) ^ r7) << 4; a.ch1 = ((4 + 2 * blk + (pp >> 1)) ^ r7) << 4; return a;
}
__device__ __forceinline__ void pv_half_tr(const LAS unsigned char* vb, const unsigned (&pw)[8], const TrAddr& ta, int hf, f32x16& o0, f32x16& o1, f32x16& os, bf16x8 ones) {
    const LAS unsigned char* v0 = vb + ta.base0;
    v2u a0[2], a1[2], b0[2], b1[2];
#pragma unroll
    for (int s2 = 0; s2 < 2; ++s2) { const int ro = (2 * hf + s2) * 2048;
        a0[s2] = vtr8(v0 + ro + ta.ch0); a1[s2] = vtr8(v0 + ro + 1024 + ta.ch0); b0[s2] = vtr8(v0 + ro + ta.ch1); b1[s2] = vtr8(v0 + ro + 1024 + ta.ch1); }
#pragma unroll
    for (int s2 = 0; s2 < 2; ++s2) {
        const v4u pu = {pw[4 * s2], pw[4 * s2 + 1], pw[4 * s2 + 2], pw[4 * s2 + 3]};
        const bf16x8 pf = __builtin_bit_cast(bf16x8, pu);
        const v4u au = {a0[s2].x, a0[s2].y, a1[s2].x, a1[s2].y}, bu = {b0[s2].x, b0[s2].y, b1[s2].x, b1[s2].y};
        o0 = MFMA32(__builtin_bit_cast(bf16x8, au), pf, o0);
        o1 = MFMA32(__builtin_bit_cast(bf16x8, bu), pf, o1);
        os = MFMA32(ones, pf, os);
    }
}
__device__ __forceinline__ void pv_tile_tr(const LAS unsigned char* vb, const unsigned (&pw)[16], const TrAddr& ta, f32x16& o0, f32x16& o1) {
    const LAS unsigned char* v0 = vb + ta.base0;
#pragma unroll
    for (int sl = 0; sl < 4; ++sl) {
        const v4u pu = {pw[4 * sl], pw[4 * sl + 1], pw[4 * sl + 2], pw[4 * sl + 3]};
        const bf16x8 pf = __builtin_bit_cast(bf16x8, pu);
        const v2u a0 = vtr8(v0 + sl * 2048 + ta.ch0), a1 = vtr8(v0 + sl * 2048 + 1024 + ta.ch0), b0 = vtr8(v0 + sl * 2048 + ta.ch1), b1 = vtr8(v0 + sl * 2048 + 1024 + ta.ch1);
        const v4u au = {a0.x, a0.y, a1.x, a1.y}, bu = {b0.x, b0.y, b1.x, b1.y};
        o0 = MFMA32(__builtin_bit_cast(bf16x8, au), pf, o0);
        o1 = MFMA32(__builtin_bit_cast(bf16x8, bu), pf, o1);
    }
}
#define PACK_P(pw, s0, s1) do { _Pragma("unroll") for (int r_ = 0; r_ < 8; ++r_) { pw[r_] = pk2(s0[2 * r_], s0[2 * r_ + 1]); pw[8 + r_] = pk2(s1[2 * r_], s1[2 * r_ + 1]); } } while (0)
__device__ __forceinline__ int msb64(unsigned long long x) { return 63 - __builtin_clzll(x); }

__device__ __forceinline__ void nsa_unit(const Params& p, LAS unsigned char* lds, int b, int hkv, int i, int tid, int lane, int wave) {
    asm volatile("" : "+v"(tid)); lane = tid & 63;
    unsigned char* ws = p.ws;
    const bf16* Z = (const bf16*)(ws + WS_Z);
    const int col = lane & 31, hi = lane >> 5, g = col >> 3, qp = col & 7;
    const int tq = 8 * wave + qp, t = 64 * i + tq, head = 4 * hkv + g;
    const size_t tok = (size_t)b * S + t;
    const LAS float* lut = (const LAS float*)(lds + LUT_OFF) + head * 128;
    const float bias_far = lut[127];
    LAS float* impw = (LAS float*)(lds + ACC_OFF + wave * 8192);
    LAS float* impw3 = impw + 512;
    LAS float* accs = (LAS float*)(lds + ACC_OFF + wave * 8192) + lane;
    LAS unsigned long long* selor = (LAS unsigned long long*)(lds + MISC4_OFF);
    Ring rg; rg.init(lds, lane, wave);
    const TrAddr tra = tr_addr(lane);
    bf16x8 qf[4];
#pragma unroll
    for (int d0 = 0; d0 < 4; ++d0) qf[d0] = *(const bf16x8*)(Z + tok * ZW + ZQ + head * 64 + d0 * 16 + hi * 8);
    const float* gates = (const float*)(ws + WS_G) + tok * 24 + hkv * 12 + g * 3;
    const float g_c = gates[0], g_s = gates[1], g_w = gates[2];
    const LAS float* pmisc = (const LAS float*)(lds + MISC4_OFF + 2304);
    const bool fastp = pmisc[2] != 0.f;
    float qnorm;
    { float q2 = 0.f;
#pragma unroll
      for (int d0 = 0; d0 < 4; ++d0) { const v4u u = __builtin_bit_cast(v4u, qf[d0]);
          q2 += bflo(u.x) * bflo(u.x) + bfhi(u.x) * bfhi(u.x) + bflo(u.y) * bflo(u.y) + bfhi(u.y) * bfhi(u.y) + bflo(u.z) * bflo(u.z) + bfhi(u.z) * bfhi(u.z) + bflo(u.w) * bflo(u.w) + bfhi(u.w) * bfhi(u.w); }
      q2 += __shfl_xor(q2, 32);
      qnorm = sqrtf(q2) * 1.002f; }
    const bf16* KC = (const bf16*)(ws + WS_KC) + (size_t)(b * 2 + hkv) * 256 * 64;
    const bf16* VCT = (const bf16*)(ws + WS_VCT) + (size_t)(b * 2 + hkv) * 64 * 256;
    const int ntc = (i >> 4) + 1;
    const int cbase = 64 * i + tq - 31 - 64 * hi;
    float m = NEGBIG, l = 0.f;
    RING_DRAIN();
    for (int k = 0; k < 3 && k < ntc; ++k) rg.issue(KC + (size_t)k * 64 * 64, 64, VCT + k * 64, 256, k);
    for (int it = 0; it < ntc; ++it) {
        const int ahead = ntc - 1 - it;
        RING_WAIT(ahead);
        if (it + 3 < ntc) rg.issue(KC + (size_t)(it + 3) * 64 * 64, 64, VCT + (it + 3) * 64, 256, (it + 3) & 3);
        f32x16 s0, s1;
        const bool allfar = (64 * i + 8 * wave - 31 - 1024 * it - 1008) >= 128;
        float mx = NEGBIG;
        if (allfar) {
            qk_tile(lds + (it & 3) * STG_BYTES, qf, col, hi, s0, s1, bias_far);
#pragma unroll
            for (int r = 0; r < 16; ++r) mx = fmaxf(mx, fmaxf(s0[r], s1[r]));
        } else {
            qk_tile(lds + (it & 3) * STG_BYTES, qf, col, hi, s0, s1, 0.f);
            const int db = cbase - 1024 * it;
#pragma unroll
            for (int r = 0; r < 16; ++r) {
                const int d0_ = db - 16 * KKOF(0, r), d1_ = db - 16 * KKOF(1, r);
                const float x0 = s0[r] + lut[min(max(d0_, 0), 127)], x1 = s1[r] + lut[min(max(d1_, 0), 127)];
                s0[r] = d0_ >= 0 ? x0 : NEGBIG; s1[r] = d1_ >= 0 ? x1 : NEGBIG;
                mx = fmaxf(mx, fmaxf(s0[r], s1[r]));
            }
        }
        mx = fmaxf(mx, __shfl_xor(mx, 32));
        const float mn = fmaxf(m, mx);
        float ps = 0.f;
#pragma unroll
        for (int r = 0; r < 16; ++r) { ps += (s0[r] > -1.0e29f ? ex2(s0[r] - mn) : 0.f) + (s1[r] > -1.0e29f ? ex2(s1[r] - mn) : 0.f); }
        l = l * ex2(m - mn) + ps; m = mn;
    }
    WAITV_BAR(0);
    l += __shfl_xor(l, 32);
    const float inv_lc = l > 0.f ? rcp(l) : 0.f;
    f32x16 oc0, oc1;
#pragma unroll
    for (int r = 0; r < 16; ++r) { oc0[r] = 0.f; oc1[r] = 0.f; }
    for (int it = 0; it < ntc; ++it) {
        f32x16 s0, s1;
        const bool allfar = (64 * i + 8 * wave - 31 - 1024 * it - 1008) >= 128;
        if (allfar) {
            qk_tile(lds + (it & 3) * STG_BYTES, qf, col, hi, s0, s1, bias_far - m);
#pragma unroll
            for (int r = 0; r < 16; ++r) { s0[r] = ex2(s0[r]) * inv_lc; s1[r] = ex2(s1[r]) * inv_lc; }
        } else {
            qk_tile(lds + (it & 3) * STG_BYTES, qf, col, hi, s0, s1, 0.f);
            const int db = cbase - 1024 * it;
#pragma unroll
            for (int r = 0; r < 16; ++r) {
                const int d0_ = db - 16 * KKOF(0, r), d1_ = db - 16 * KKOF(1, r);
                const float x0 = s0[r] + lut[min(max(d0_, 0), 127)], x1 = s1[r] + lut[min(max(d1_, 0), 127)];
                s0[r] = d0_ >= 0 ? ex2(x0 - m) * inv_lc : 0.f; s1[r] = d1_ >= 0 ? ex2(x1 - m) * inv_lc : 0.f;
            }
        }
#pragma unroll
        for (int k4 = 0; k4 < 4; ++k4) {
            float pa0 = (s0[4 * k4] + s0[4 * k4 + 1]) + (s0[4 * k4 + 2] + 0.5f * s0[4 * k4 + 3]), pc0 = 0.5f * s0[4 * k4 + 3];
            float pa1 = (s1[4 * k4] + s1[4 * k4 + 1]) + (s1[4 * k4 + 2] + 0.5f * s1[4 * k4 + 3]), pc1 = 0.5f * s1[4 * k4 + 3];
            pa0 += __shfl_xor(pa0, 8); pa0 += __shfl_xor(pa0, 16); pc0 += __shfl_xor(pc0, 8); pc0 += __shfl_xor(pc0, 16);
            pa1 += __shfl_xor(pa1, 8); pa1 += __shfl_xor(pa1, 16); pc1 += __shfl_xor(pc1, 8); pc1 += __shfl_xor(pc1, 16);
            if (g == 0) { const int n0 = 16 * it + 2 * k4 + hi;
                impw[qp * 64 + n0] = pa0; impw3[qp * 64 + n0] = pc0; impw[qp * 64 + n0 + 8] = pa1; impw3[qp * 64 + n0 + 8] = pc1; }
        }
        unsigned pw[16]; PACK_P(pw, s0, s1);
        pv_tile(lds + (it & 3) * STG_BYTES + 8192, pw, col, hi, oc0, oc1);
    }
    LDS_WAIT();
    unsigned long long mysel = 0ull, wsel = 0ull;
    {
        const unsigned long long curmask = (i == 63) ? ~0ull : ((1ull << (i + 1)) - 1ull);
        const int want = i + 1 < 16 ? i + 1 : 16;
        const int n = lane;
        LAS float* vbuf = (LAS float*)(lds + MISC4_OFF + 256 + wave * 256);
        for (int q = 0; q < 8; ++q) {
            float v = impw[q * 64 + n] + (n > 0 ? impw3[q * 64 + n - 1] : 0.f) + ((n == 0 || n == i || n == i - 1) ? 1.0e4f : 0.f);
            v = (n <= i) ? v : -1.0e9f;
            vbuf[n] = v;
            LDS_WAIT();
            int cgt = 0;
#pragma unroll
            for (int m4 = 0; m4 < 16; ++m4) { const f32x4 w = *(const LAS f32x4*)(vbuf + 4 * m4); cgt += (w.x > v ? 1 : 0) + (w.y > v ? 1 : 0) + (w.z > v ? 1 : 0) + (w.w > v ? 1 : 0); }
            LDS_WAIT();
            unsigned long long sel = __ballot(cgt < 16) & curmask;
            if (__builtin_popcountll(sel) != want) {
                int rank = 0;
#pragma unroll 8
                for (int mm = 0; mm < 64; ++mm) { const float vm = vbuf[mm]; rank += (vm > v || (vm == v && mm < n)) ? 1 : 0; }
                LDS_WAIT();
                sel = __ballot(rank < 16) & curmask;
            }
            if (qp == q) mysel = sel;
            wsel |= sel;
        }
    }
    LDS_WAIT();
#pragma unroll
    for (int r = 0; r < 16; ++r) { accs[r * 64] = oc0[r] * g_c; accs[(16 + r) * 64] = oc1[r] * g_c; }
    if (lane == 0) selor[wave] = wsel;
    __syncthreads();
    unsigned long long U = 0ull;
#pragma unroll
    for (int w = 0; w < 8; ++w) U |= selor[w];
    U = ((unsigned long long)__builtin_amdgcn_readfirstlane((unsigned)(U >> 32)) << 32) | (unsigned long long)__builtin_amdgcn_readfirstlane((unsigned)U);
    const v4u onesu = {0x3f803f80u, 0x3f803f80u, 0x3f803f80u, 0x3f803f80u};
    const bf16x8 ones = __builtin_bit_cast(bf16x8, onesu);
    constexpr float THR = 8.0f;
#pragma unroll 1
    for (int mode = 0; mode < 2; ++mode) {
        const bf16* Kb = Z + (size_t)b * S * ZW + (mode ? ZKW : ZKS) + hkv * 64;
        const bf16* Vb = Z + (size_t)b * S * ZW + (mode ? ZVW : ZVS) + hkv * 64;
        unsigned long long Tm;
        if (mode == 0) Tm = U;
        else { const int jlo = i >= 8 ? i - 8 : 0; const unsigned long long hm = (i == 63) ? ~0ull : ((1ull << (i + 1)) - 1ull); Tm = hm & ~((1ull << jlo) - 1ull); }
        const unsigned long long wm = mode ? Tm : wsel;
        const unsigned long long lm = mode ? Tm : mysel;
        const int dmax = mode ? 512 : 0x40000000;
        f32x16 o0, o1, os, cfar;
#pragma unroll
        for (int r = 0; r < 16; ++r) { o0[r] = 0.f; o1[r] = 0.f; os[r] = 0.f; }
        float mref = fastp ? qnorm * pmisc[mode] + pmisc[8 + head] : 0.f;
#pragma unroll
        for (int r = 0; r < 16; ++r) cfar[r] = bias_far - mref;
        const int nt = __builtin_popcountll(Tm);
        unsigned long long irem = Tm, crem = Tm;
        for (int k = 0; k < 3 && k < nt; ++k) { const int ji = msb64(irem); irem &= ~(1ull << ji); rg.issue(Kb + (size_t)ji * 64 * ZW, ZW, Vb + (size_t)ji * 64 * ZW, ZW, k); }
        if (fastp) {
        for (int it = 0; it < nt; ++it) {
            const int j = msb64(crem); crem &= ~(1ull << j);
            const int ahead = nt - 1 - it;
            RING_WAIT(ahead);
            if (it + 3 < nt) { const int ji = msb64(irem); irem &= ~(1ull << ji); rg.issue(Kb + (size_t)ji * 64 * ZW, ZW, Vb + (size_t)ji * 64 * ZW, ZW, (it + 3) & 3); }
                if ((wm >> j) & 1ull) {
                    const LAS unsigned char* stg = lds + (it & 3) * STG_BYTES;
                    const int dj = i - j;
                    const bool lsel = (lm >> j) & 1ull;
                    const int db = 64 * dj + tq - 4 * hi;
#pragma unroll
                    for (int hf = 0; hf < 2; ++hf) {
                        f32x16 s; unsigned pw[8];
                        if (dj <= 2) {
                            qk_half(stg, qf, col, hi, hf, s, -mref);
                            const LAS float* l2p = (const LAS float*)(lds + LUT2_OFF) + head * 260 + db + 5;
#pragma unroll
                            for (int r = 0; r < 16; ++r) { const float x = s[r] + l2p[63 - KKOF(hf, r)]; s[r] = (lsel && KKOF(hf, r) <= db) ? ex2(x) : 0.f; }
#pragma unroll
                            for (int r = 0; r < 8; ++r) pw[r] = pk2(s[2 * r], s[2 * r + 1]);
                        } else if (dj == 8) {
                            qk_half_c(stg, qf, col, hi, hf, s, cfar);
#pragma unroll
                            for (int r = 0; r < 16; ++r) { const int d_ = db - KKOF(hf, r); s[r] = (lsel && d_ < dmax) ? ex2(s[r]) : 0.f; }
#pragma unroll
                            for (int r = 0; r < 8; ++r) pw[r] = pk2(s[2 * r], s[2 * r + 1]);
                        } else {
                            qk_half_c(stg, qf, col, hi, hf, s, cfar);
#pragma unroll
                            for (int r = 0; r < 8; ++r) { const unsigned w_ = pk2(ex2(s[2 * r]), ex2(s[2 * r + 1])); pw[r] = lsel ? w_ : 0u; }
                        }
                        pv_half_tr(stg + 8192, pw, tra, hf, o0, o1, os, ones);
                    }
                }
        }
        } else {
        for (int it = 0; it < nt; ++it) {
            const int j = msb64(crem); crem &= ~(1ull << j);
            const int ahead = nt - 1 - it;
            RING_WAIT(ahead);
            if (it + 3 < nt) { const int ji = msb64(irem); irem &= ~(1ull << ji); rg.issue(Kb + (size_t)ji * 64 * ZW, ZW, Vb + (size_t)ji * 64 * ZW, ZW, (it + 3) & 3); }
            if ((wm >> j) & 1ull) {
                const LAS unsigned char* stg = lds + (it & 3) * STG_BYTES;
                const int dj = i - j;
                const bool nearb = dj <= 2;
                const bool lsel = (lm >> j) & 1ull;
                const int db = 64 * dj + tq - 4 * hi;
#pragma unroll
                for (int hf = 0; hf < 2; ++hf) {
                    f32x16 s;
                    float mx = NEGBIG;
                    if (nearb) {
                        qk_half(stg, qf, col, hi, hf, s, -mref);
#pragma unroll
                        for (int r = 0; r < 16; ++r) { const int d_ = db - KKOF(hf, r); const float x = s[r] + lut[min(max(d_, 0), 127)]; s[r] = (lsel && d_ >= 0) ? x : NEGBIG; mx = fmaxf(mx, s[r]); }
                    } else if (dj == 8) {
                        qk_half(stg, qf, col, hi, hf, s, bias_far - mref);
#pragma unroll
                        for (int r = 0; r < 16; ++r) { const int d_ = db - KKOF(hf, r); s[r] = (lsel && d_ < dmax) ? s[r] : NEGBIG; mx = fmaxf(mx, s[r]); }
                    } else {
                        qk_half(stg, qf, col, hi, hf, s, lsel ? bias_far - mref : NEGBIG);
#pragma unroll
                        for (int r = 0; r < 16; ++r) mx = fmaxf(mx, s[r]);
                    }
                    { auto rr_ = __builtin_amdgcn_permlane32_swap(__float_as_uint(mx), __float_as_uint(mx), false, false); mx = fmaxf(__uint_as_float(rr_[0]), __uint_as_float(rr_[1])); }
                    if (dj == 0 && hf == 0) {
                        mref = mx;
#pragma unroll
                        for (int r = 0; r < 16; ++r) s[r] -= mx;
                    } else if (__any(mx > THR)) {
                        const float dl = mx > THR ? mx : 0.f; mref += dl; const float scl = ex2(-dl);
#pragma unroll
                        for (int r = 0; r < 16; ++r) s[r] -= dl;
                        o0 = o0 * scl; o1 = o1 * scl; os = os * scl;
                    }
                    unsigned pw[8];
#pragma unroll
                    for (int r = 0; r < 8; ++r) pw[r] = pk2(ex2(s[2 * r]), ex2(s[2 * r + 1]));
                    pv_half_tr(stg + 8192, pw, tra, hf, o0, o1, os, ones);
                }
            }
        }
        }
        WAITV_BAR(0);
        l = os[0];
        const float f = (mode ? g_w : g_s) * (l > 0.f ? rcp(l) : 0.f);
        if (mode == 0) {
#pragma unroll
            for (int r = 0; r < 16; ++r) { accs[r * 64] += o0[r] * f; accs[(16 + r) * 64] += o1[r] * f; }
        } else {
            bf16* O = (bf16*)(ws + WS_ATTA) + tok * 1024 + head * 64 + 4 * hi;
#pragma unroll
            for (int r = 0; r < 16; ++r) { o0[r] = accs[r * 64] + o0[r] * f; o1[r] = accs[(16 + r) * 64] + o1[r] * f; }
#pragma unroll
            for (int k4 = 0; k4 < 4; ++k4) {
                v2u w0; w0.x = pk2(o0[4 * k4], o0[4 * k4 + 1]); w0.y = pk2(o0[4 * k4 + 2], o0[4 * k4 + 3]);
                v2u w1; w1.x = pk2(o1[4 * k4], o1[4 * k4 + 1]); w1.y = pk2(o1[4 * k4 + 2], o1[4 * k4 + 3]);
                *(v2u*)(O + 8 * k4) = w0; *(v2u*)(O + 32 + 8 * k4) = w1;
            }
        }
    }
}

template <bool MK> __device__ __forceinline__ void sb_scan(f32x16& s0, f32x16& s1, int db, int hi, float& R) {
            f32x16 k0, k1;
#pragma unroll
            for (int r = 0; r < 16; ++r) {
                const float e0 = ex2(fminf(s0[r], 80.f)), e1 = ex2(fminf(s1[r], 80.f));
                const float p0 = rcp(1.0f + e0), p1 = rcp(1.0f + e1);
                s0[r] = e0 * p0; s1[r] = e1 * p1;
                k0[r] = (!MK || KKOF(0, r) < db) ? p0 : 1.0f; k1[r] = (!MK || KKOF(1, r) < db) ? p1 : 1.0f;
            }
            float g4[8], pg[8], E[8];
#pragma unroll
            for (int k4 = 0; k4 < 4; ++k4) { g4[k4] = (k0[4 * k4] * k0[4 * k4 + 1]) * (k0[4 * k4 + 2] * k0[4 * k4 + 3]); g4[4 + k4] = (k1[4 * k4] * k1[4 * k4 + 1]) * (k1[4 * k4 + 2] * k1[4 * k4 + 3]); }
#pragma unroll
            for (int G = 0; G < 8; ++G) pg[G] = __shfl_xor(g4[G], 32);
            E[7] = 1.0f;
#pragma unroll
            for (int G = 6; G >= 0; --G) E[G] = E[G + 1] * (g4[G + 1] * pg[G + 1]);
            const float T = E[0] * (g4[0] * pg[0]);
#pragma unroll
            for (int G = 0; G < 8; ++G) {
                const float base = R * E[G] * (hi == 0 ? pg[G] : 1.0f);
                const int k4 = G & 3;
                if (G < 4) {
                    const float u3 = base, u2 = u3 * k0[4 * k4 + 3], u1 = u2 * k0[4 * k4 + 2], u0 = u1 * k0[4 * k4 + 1];
                    s0[4 * k4 + 3] = (!MK || KKOF(0, 4 * k4 + 3) < db) ? s0[4 * k4 + 3] * u3 : 0.f;
                    s0[4 * k4 + 2] = (!MK || KKOF(0, 4 * k4 + 2) < db) ? s0[4 * k4 + 2] * u2 : 0.f;
                    s0[4 * k4 + 1] = (!MK || KKOF(0, 4 * k4 + 1) < db) ? s0[4 * k4 + 1] * u1 : 0.f;
                    s0[4 * k4 + 0] = (!MK || KKOF(0, 4 * k4 + 0) < db) ? s0[4 * k4 + 0] * u0 : 0.f;
                } else {
                    const float u3 = base, u2 = u3 * k1[4 * k4 + 3], u1 = u2 * k1[4 * k4 + 2], u0 = u1 * k1[4 * k4 + 1];
                    s1[4 * k4 + 3] = (!MK || KKOF(1, 4 * k4 + 3) < db) ? s1[4 * k4 + 3] * u3 : 0.f;
                    s1[4 * k4 + 2] = (!MK || KKOF(1, 4 * k4 + 2) < db) ? s1[4 * k4 + 2] * u2 : 0.f;
                    s1[4 * k4 + 1] = (!MK || KKOF(1, 4 * k4 + 1) < db) ? s1[4 * k4 + 1] * u1 : 0.f;
                    s1[4 * k4 + 0] = (!MK || KKOF(1, 4 * k4 + 0) < db) ? s1[4 * k4 + 0] * u0 : 0.f;
                }
            }
            R *= T;
}

__device__ __forceinline__ void sb_unit(const Params& p, LAS unsigned char* lds, int b, int hp, int qb, int tid, int lane, int wave) {
    asm volatile("" : "+v"(tid)); lane = tid & 63;
    unsigned char* ws = p.ws;
    const bf16* Z = (const bf16*)(ws + WS_Z);
    const int col = lane & 31, hi = lane >> 5, w4 = wave & 3, hsel = wave >> 2, h = 2 * hp + hsel;
    const int t = 128 * qb + 32 * w4 + col;
    const size_t tok = (size_t)b * S + t;
    const int tmaxw = 128 * qb + 32 * w4 + 31;
    LAS int* flags = (LAS int*)(lds + MISC4_OFF + 128);
    Ring rg; rg.init(lds, lane, wave);
    bf16x8 qf[4];
#pragma unroll
    for (int d0 = 0; d0 < 4; ++d0) { const v4u raw = *(const v4u*)(Z + tok * ZW + ZQB + h * 64 + d0 * 16 + hi * 8);
        constexpr float QS = 0.125f * LOG2E;
        v4u sc; sc.x = pk2(bflo(raw.x) * QS, bfhi(raw.x) * QS); sc.y = pk2(bflo(raw.y) * QS, bfhi(raw.y) * QS);
        sc.z = pk2(bflo(raw.z) * QS, bfhi(raw.z) * QS); sc.w = pk2(bflo(raw.w) * QS, bfhi(raw.w) * QS);
        qf[d0] = __builtin_bit_cast(bf16x8, sc); }
    const bf16* Kb = Z + (size_t)b * S * ZW + ZKB + 2 * hp * 64;
    const bf16* Vb = Z + (size_t)b * S * ZW + ZVB + 2 * hp * 64;
    const TrAddr tra = tr_addr(lane);
    f32x16 o0, o1;
#pragma unroll
    for (int r = 0; r < 16; ++r) { o0[r] = 0.f; o1[r] = 0.f; }
    float R = 1.0f; bool dead = false;
    const int jtop = 2 * qb + 1, nt = jtop + 1;
    if (tid < 16) flags[tid] = 0;
    RING_DRAIN();
    for (int k = 0; k < 3 && k < nt; ++k) rg.issue4(Kb + (size_t)(jtop - k) * 64 * ZW, Vb + (size_t)(jtop - k) * 64 * ZW, ZW, k);
    for (int it = 0; it < nt; ++it) {
        const int j = jtop - it;
        const int ahead = nt - 1 - it;
        RING_WAIT4(ahead);
        if (it > 0) { int alld = 1;
#pragma unroll
            for (int w = 0; w < 8; ++w) alld &= flags[((it - 1) & 1) * 8 + w];
            if (alld) break; }
        if (it + 3 < nt) rg.issue4(Kb + (size_t)(j - 3) * 64 * ZW, Vb + (size_t)(j - 3) * 64 * ZW, ZW, (it + 3) & 3);
        if (!dead && 64 * j < tmaxw) {
            const LAS unsigned char* stg = lds + (it & 3) * (2 * STG_BYTES) + hsel * STG_BYTES;
            f32x16 s0, s1;
            qk_tile(stg, qf, col, hi, s0, s1, 0.f);
            const int db = t - 64 * j - 4 * hi;
            if (64 * j + 63 < tmaxw - 31) sb_scan<false>(s0, s1, db, hi, R); else sb_scan<true>(s0, s1, db, hi, R);
            unsigned pw[16]; PACK_P(pw, s0, s1);
            pv_tile_tr(stg + 8192, pw, tra, o0, o1);
            dead = __all(R < 1.0e-44f);
        }
        if (lane == 0) flags[(it & 1) * 8 + wave] = dead ? 1 : 0;
    }
    WAITV_BAR(0);
    bf16* O = (bf16*)(ws + WS_ATTA) + tok * 1024 + 512 + h * 64 + 4 * hi;
#pragma unroll
    for (int k4 = 0; k4 < 4; ++k4) {
        v2u w0; w0.x = pk2(o0[4 * k4], o0[4 * k4 + 1]); w0.y = pk2(o0[4 * k4 + 2], o0[4 * k4 + 3]);
        v2u w1; w1.x = pk2(o1[4 * k4], o1[4 * k4 + 1]); w1.y = pk2(o1[4 * k4 + 2], o1[4 * k4 + 3]);
        *(v2u*)(O + 8 * k4) = w0; *(v2u*)(O + 32 + 8 * k4) = w1;
    }
}

__device__ __forceinline__ void phase4(const Params& p, LAS unsigned char* lds, int tid, int lane, int wave) {
    for (int vb = blockIdx.x; vb < 256; vb += gridDim.x) {
    const int v = (vb & 7) * 32 + (vb >> 3);
    __syncthreads();
    { const float* rel = p.in[2]; LAS float* lut = (LAS float*)(lds + LUT_OFF);
      for (int e = tid; e < 1024; e += 512) { const int head = e >> 7, dist = e & 127;
          int bk = dist; if (dist >= 16) { bk = 16 + (int)(logf((float)dist / 16.0f) / 2.0794415416798357f * 16.0f); bk = bk < 31 ? bk : 31; }
          lut[e] = rel[bk * 8 + head] * LOG2E; } }
    __syncthreads();
    { const LAS float* lut = (const LAS float*)(lds + LUT_OFF); LAS float* l2 = (LAS float*)(lds + LUT2_OFF);
      for (int e = tid; e < 8 * 260; e += 512) { const int head = e / 260, d = e % 260 - 68; l2[e] = d < 0 ? 0.f : lut[head * 128 + (d < 127 ? d : 127)]; } }
    if (wave == 0) { const float* qg = p.in[13]; const float* kg = p.in[14]; LAS float* pm = (LAS float*)(lds + MISC4_OFF + 2304); const LAS float* lut = (const LAS float*)(lds + LUT_OFF);
        float a = fabsf(qg[lane]), b1 = fabsf(kg[64 + lane]), b2 = fabsf(kg[128 + lane]);
#pragma unroll
        for (int o = 1; o < 64; o <<= 1) { a = fmaxf(a, __shfl_xor(a, o)); b1 = fmaxf(b1, __shfl_xor(b1, o)); b2 = fmaxf(b2, __shfl_xor(b2, o)); }
        float bm = -1.0e30f, ball = 0.f;
        if (lane < 8) {
            for (int d = 0; d < 128; ++d) bm = fmaxf(bm, lut[lane * 128 + d]);
            pm[8 + lane] = bm; }
        ball = lane < 8 ? bm : -1.0e30f;
#pragma unroll
        for (int o = 1; o < 64; o <<= 1) ball = fmaxf(ball, __shfl_xor(ball, o));
        const float kn1 = 8.0f * b1 * 1.004f, kn2 = 8.0f * b2 * 1.004f, qmax = 8.0f * a * 0.125f * LOG2E * 1.004f;
        const float worst = qmax * fmaxf(kn1, kn2) + fmaxf(ball, 0.f);
        if (lane == 0) { pm[0] = kn1; pm[1] = kn2; pm[2] = (worst < 48.0f) ? 1.0f : 0.0f; } }
    __syncthreads();
        { const int pair = v >> 3, s = v & 7, b = pair >> 1, hkv = pair & 1;
#pragma unroll 1
          for (int u = 0; u < 8; ++u) { const int i = (u & 1) ? (16 * (u >> 1) + 15 - s) : (16 * (u >> 1) + s);
 for (int rep_ = 0; rep_ < REP_NSA; ++rep_) nsa_unit(p, lds, b, hkv, i, tid, lane, wave);
 } }
        { const int pair = v >> 2, b = pair >> 2, hp = pair & 3;
#pragma unroll 1
          for (int u = 0; u < 8; ++u) { const int qb = (v & 3) + 4 * u;
 for (int rep_ = 0; rep_ < REP_SB; ++rep_) sb_unit(p, lds, b, hp, qb, tid, lane, wave);
 } }
    }
}

__global__ void __launch_bounds__(NWAVES * 64, 2) fwd_megakernel(Params p) {
    extern __shared__ __attribute__((aligned(16))) unsigned char lds_raw[];
    LAS unsigned char* lds = (LAS unsigned char*)lds_raw;
    cg::grid_group grid = cg::this_grid();
    int tid = threadIdx.x, lane = tid & 63, wave = __builtin_amdgcn_readfirstlane(tid >> 6);
#define RELAUNDER() do { tid = threadIdx.x; asm volatile("" : "+v"(tid)); lane = tid & 63; wave = __builtin_amdgcn_readfirstlane(tid >> 6); } while (0)
    unsigned char* ws = p.ws;
    bf16* XN = (bf16*)(ws + WS_XN); bf16* Zb = (bf16*)(ws + WS_Z); float* mod = (float*)(ws + WS_MOD);
    const int G = gridDim.x;

    RELAUNDER();
    for (int rep_ = 0; rep_ < REP_P0; ++rep_) { phase0(p, lds, tid, lane, wave); __syncthreads(); }
    grid.sync();
    RELAUNDER();
    for (int rep_ = 0; rep_ < REP_P1; ++rep_) norm_rows(p.in[0], p.in[5], mod, 0, 1024, XN, lane, wave);
    grid.sync();
    { pg8::Gemm g{XN, (const bf16*)(ws + WS_WIN), M, NIN, DM}; pg8::StaticOrder So; So.init(M, NIN, G, (int)blockIdx.x);
      pg8::EpiZ E{Zb, (float*)(ws + WS_G)};
      pg8::gemm_phase<pg8::EpiZ, pg8::StaticOrder, true, true>(lds, g, So, E); }
    grid.sync();
    RELAUNDER();
    for (int rep_ = 0; rep_ < REP_P3; ++rep_) { phase3(p, lds, tid, lane, wave, rep_ == 0); __syncthreads(); }
    grid.sync();
    RELAUNDER();
#ifndef SKIP_P4
    phase4(p, lds, tid, lane, wave);
#endif
    grid.sync();
    { pg8::Gemm g{(const bf16*)(ws + WS_ATTA), (const bf16*)(ws + WS_WUPA), M, DM, DM}; pg8::StaticOrder So; So.init(M, DM, G, (int)blockIdx.x);
      pg8::EpiUpF E{XN, Zb};
      pg8::gemm_phase<pg8::EpiUpF, pg8::StaticOrder, true, true>(lds, g, So, E); }
    grid.sync();
    { pg8::Gemm g{XN, (const bf16*)(ws + WS_WOUT), M, DM, DM}; pg8::StaticOrder So; So.init(M, DM, G, (int)blockIdx.x);
      pg8::EpiRes2 E{p.in[0], p.out, mod + 2048, p.in[6], mod + 4096, (bf16*)(ws + WS_ATTA), (float*)(ws + WS_ROWSS)};
      pg8::gemm_phase<pg8::EpiRes2, pg8::StaticOrder, true, true>(lds, g, So, E); }
    grid.sync();
    { pg8::Gemm g{(const bf16*)(ws + WS_ATTA), (const bf16*)(ws + WS_W1), M, FF, DM}; pg8::StaticOrder So; So.init(M, FF, G, (int)blockIdx.x);
      pg8::EpiRelu2N E{Zb, (const float*)(ws + WS_ROWSS), (const float*)(ws + WS_SW)};
      pg8::gemm_phase<pg8::EpiRelu2N, pg8::StaticOrder, true, true>(lds, g, So, E); }
    grid.sync();
    { pg8::Gemm g{Zb, (const bf16*)(ws + WS_W2), M, DM, FF}; pg8::StaticOrder So; So.init(M, DM, G, (int)blockIdx.x);
      pg8::EpiRes E{p.out, p.out, mod + 5120};
      pg8::gemm_phase<pg8::EpiRes, pg8::StaticOrder, true, true>(lds, g, So, E); }
}

extern "C" void kernel_launch(void* const* d_in, const int* in_sizes, int n_in, void* d_out, int out_size, void* d_ws, size_t ws_size, hipStream_t stream) {
    static int grid = 0;
    if (grid == 0) {
        if (n_in != 20 || ws_size < WS_END) { fprintf(stderr, "kernel_launch: unexpected inputs (n_in %d, ws %zu)\n", n_in, ws_size); grid = -1; return; }
        int dev = 0, cus = 0, per_cu = 0;
        hipGetDevice(&dev); hipDeviceGetAttribute(&cus, hipDeviceAttributeMultiprocessorCount, dev);
        if (hipFuncSetAttribute((const void*)fwd_megakernel, hipFuncAttributeMaxDynamicSharedMemorySize, LDS_BYTES) != hipSuccess) fprintf(stderr, "kernel_launch: hipFuncSetAttribute failed\n");
        if (hipOccupancyMaxActiveBlocksPerMultiprocessor(&per_cu, (const void*)fwd_megakernel, NWAVES * 64, LDS_BYTES) != hipSuccess || per_cu < 1) { fprintf(stderr, "kernel_launch: occupancy query gave %d\n", per_cu); per_cu = 1; }
        (void)hipGetLastError();
        grid = cus * per_cu;
    }
    if (grid < 0) return;
    Params p{};
    for (int i = 0; i < 20; ++i) p.in[i] = (const float*)d_in[i];
    p.out = (float*)d_out; p.ws = (unsigned char*)d_ws;
    void* args[] = {&p};
    hipError_t e = hipLaunchCooperativeKernel((const void*)fwd_megakernel, dim3(grid), dim3(NWAVES * 64), args, LDS_BYTES, stream);
    if (e != hipSuccess) fprintf(stderr, "kernel_launch: cooperative launch failed: %s (grid %d)\n", hipGetErrorString(e), grid);
}
```

```cpp
#include <hip/hip_runtime.h>
#include <hip/hip_cooperative_groups.h>
#include <cstdio>
#include <cstdint>
namespace cg = cooperative_groups;

constexpr int NB = 16, S = 4096, DM = 1024, M = NB * S, FF = 4096;
constexpr int ZW = 4864;
constexpr int ZQ = 0, ZKC = 512, ZVC = 640, ZKS = 768, ZVS = 896, ZKW = 1024, ZVW = 1152, ZQB = 1280, ZKB = 1792, ZVB = 2304, ZMA = 2816, ZMB = 3840;
constexpr int NIN = 5120;
constexpr size_t MiB = (size_t)1 << 20;
constexpr size_t WS_WIN = 1 * MiB, WS_WUPA = 11 * MiB, WS_WUPB = 12 * MiB, WS_WOUT = 13 * MiB, WS_W1 = 15 * MiB, WS_W2 = 23 * MiB;
constexpr size_t WS_MOD = 31 * MiB, WS_PW1 = 31 * MiB + 400 * 1024, WS_CW1K = 31 * MiB + 512 * 1024, WS_CW1V = WS_CW1K + 256 * 1024;
constexpr size_t WS_KC = 32 * MiB, WS_VCT = 33 * MiB, WS_VST = 34 * MiB, WS_VWT = 50 * MiB, WS_VBT = 66 * MiB;
constexpr size_t WS_XN = 130 * MiB, WS_ATTA = 258 * MiB, WS_ATTB = 322 * MiB, WS_Z = 386 * MiB, WS_G = 994 * MiB, WS_ROWSS = 1000 * MiB, WS_SW = 1001 * MiB, WS_END = 1002 * MiB;
constexpr float LOG2E = 1.4426950408889634f, LN2 = 0.6931471805599453f;
#ifndef REP_NSA
#define REP_NSA 1
#endif
#ifndef REP_SB
#define REP_SB 1
#endif
#define REP_P0 1
#define REP_P1 1
#define REP_P3 1
namespace pg8 {
#define PG8_LAS __attribute__((address_space(3)))
typedef unsigned short bf16_t;
typedef short bf16x8 __attribute__((ext_vector_type(8)));
typedef float f32x4 __attribute__((ext_vector_type(4)));
typedef unsigned u32x4 __attribute__((ext_vector_type(4)));
constexpr int BM = 256, BK = 64, HALF = 128, HTB = HALF * BK * 2  , STAGE_BYTES = 8 * HTB, NXCD = 8, WGM = 8;

__host__ __device__ __forceinline__ int lds_byte(int r, int c) { const int st = (r >> 4) * 2 + (c >> 5), rr = r & 15, cc = c & 31, ob = rr * 64 + cc * 2; return st * 1024 + (ob ^ (((ob >> 9) & 1) << 5)); }
__host__ __device__ __forceinline__ void stage_rc(int b, int& R, int& C) { const int st = b / 1024, sb = b % 1024, swz = sb ^ (((sb >> 9) & 1) << 5); R = (st >> 1) * 16 + swz / 64; C = (st & 1) * 32 + (swz % 64) / 2; }
__host__ __device__ __forceinline__ int perm32(int rho) { const int n = rho >> 4, i = rho & 15; return 8 * (i >> 2) + 4 * n + (i & 3); }

struct Unit { int pm, pn; };
struct Gemm { const bf16_t* A; const bf16_t* Bt; int M, N, K; };

struct StaticOrder {
    int nM, nN, nwg, G, c;
    __host__ __device__ void init(int M, int N, int G_, int c_) { nM = M / BM; nN = N / BM; nwg = nM * nN; G = G_; c = c_; }
    __host__ __device__ bool next(int i, Unit& u) const {
        const long L = (long)i * G + c; if (L >= nwg) return false;
        int wgid = (int)L; { const int q = nwg / NXCD, r = nwg % NXCD, xcd = wgid % NXCD, off = wgid / NXCD; wgid = (xcd < r ? xcd * (q + 1) : r * (q + 1) + (xcd - r) * q) + off; }
        const int nig = WGM * nN, gid = wgid / nig, fm = gid * WGM, gsz = (nM - fm) < WGM ? (nM - fm) : WGM;
        u.pm = fm + ((wgid % nig) % gsz); u.pn = (wgid % nig) / gsz; return true;
    }
    __device__ __forceinline__ void a_ready(const Unit&) const {}
    __device__ __forceinline__ void done(const Unit&) const {}
};

__device__ __forceinline__ unsigned cvt_pk_bf16(float lo, float hi) { unsigned r; asm volatile("v_cvt_pk_bf16_f32 %0, %1, %2" : "=v"(r) : "v"(lo), "v"(hi)); return r; }
__device__ __forceinline__ float sigm(float x) { return __builtin_amdgcn_rcpf(1.0f + __builtin_amdgcn_exp2f(-1.4426950408889634f * x)); }
__device__ __forceinline__ float bflo(unsigned u) { return __uint_as_float(u << 16); }
__device__ __forceinline__ float bfhi(unsigned u) { return __uint_as_float(u & 0xffff0000u); }
struct EpiZ {
    static constexpr bool PERM = true, AFTER_DRAIN = false, HAS_MID = false;
    bf16_t* Z; float* G;
    __device__ __forceinline__ void operator()(const f32x4 (&acc)[2][2][4][2], const Unit& u, int wr, int wc, int fr, int fq) const {
        const int row0 = u.pm * BM + wr * 64 + fr; const int colt = u.pn * BM + wc * 32 + 8 * fq;
        if (u.pn < 19) {
            const bool sg = u.pn >= 11;
#pragma unroll
            for (int ai = 0; ai < 2; ++ai)
#pragma unroll
                for (int m = 0; m < 4; ++m) { bf16_t* rowp = Z + (size_t)(row0 + ai * HALF + m * 16) * ZW + colt;
#pragma unroll
                    for (int bj = 0; bj < 2; ++bj) { f32x4 v0 = acc[ai][bj][m][0], v1 = acc[ai][bj][m][1];
                        if (sg) { v0 = (f32x4){sigm(v0[0]), sigm(v0[1]), sigm(v0[2]), sigm(v0[3])}; v1 = (f32x4){sigm(v1[0]), sigm(v1[1]), sigm(v1[2]), sigm(v1[3])}; }
                        u32x4 w; w.x = cvt_pk_bf16(v0[0], v0[1]); w.y = cvt_pk_bf16(v0[2], v0[3]); w.z = cvt_pk_bf16(v1[0], v1[1]); w.w = cvt_pk_bf16(v1[2], v1[3]);
                        *(u32x4*)(rowp + bj * HALF) = w; } }
        } else if (wc == 0 && fq < 3) {
#pragma unroll
            for (int ai = 0; ai < 2; ++ai)
#pragma unroll
                for (int m = 0; m < 4; ++m) { float* gp = G + (size_t)(row0 + ai * HALF + m * 16) * 24 + 8 * fq; const f32x4 v0 = acc[ai][0][m][0], v1 = acc[ai][0][m][1];
                    *(f32x4*)gp = (f32x4){sigm(v0[0]), sigm(v0[1]), sigm(v0[2]), sigm(v0[3])}; *(f32x4*)(gp + 4) = (f32x4){sigm(v1[0]), sigm(v1[1]), sigm(v1[2]), sigm(v1[3])}; }
        }
    }
};
__device__ __forceinline__ float gclamp(float g) { return g > 1.0e-20f ? g : 1.0e-20f; }
struct EpiUpF {
    static constexpr bool PERM = true, AFTER_DRAIN = false, HAS_MID = true;
    bf16_t* Y; const bf16_t* Zg;
    __device__ __forceinline__ void mid(f32x4 (&acc)[2][2][4][2], const Unit& u, int wr, int wc, int fr, int fq) const {
        int row0 = u.pm * BM + wr * 64 + fr; int colt = u.pn * BM + wc * 32 + 8 * fq;
        asm volatile("" : "+v"(row0), "+v"(colt));
#pragma unroll
        for (int ai = 0; ai < 2; ++ai)
#pragma unroll
            for (int m = 0; m < 4; ++m) { const size_t row = (size_t)(row0 + ai * HALF + m * 16);
#pragma unroll
                for (int bj = 0; bj < 2; ++bj) { const int col = colt + bj * HALF;
                    const u32x4 ga = *(const u32x4*)(Zg + row * ZW + ZMA + col), gb = *(const u32x4*)(Zg + row * ZW + ZMB + col);
                    f32x4& a0 = acc[ai][bj][m][0]; f32x4& a1 = acc[ai][bj][m][1];
                    a0[0] *= bflo(ga.x) * __builtin_amdgcn_rcpf(gclamp(bflo(gb.x))); a0[1] *= bfhi(ga.x) * __builtin_amdgcn_rcpf(gclamp(bfhi(gb.x)));
                    a0[2] *= bflo(ga.y) * __builtin_amdgcn_rcpf(gclamp(bflo(gb.y))); a0[3] *= bfhi(ga.y) * __builtin_amdgcn_rcpf(gclamp(bfhi(gb.y)));
                    a1[0] *= bflo(ga.z) * __builtin_amdgcn_rcpf(gclamp(bflo(gb.z))); a1[1] *= bfhi(ga.z) * __builtin_amdgcn_rcpf(gclamp(bfhi(gb.z)));
                    a1[2] *= bflo(ga.w) * __builtin_amdgcn_rcpf(gclamp(bflo(gb.w))); a1[3] *= bfhi(ga.w) * __builtin_amdgcn_rcpf(gclamp(bfhi(gb.w))); }
                if (m & 1) asm volatile("" ::: "memory"); }
    }
    __device__ __forceinline__ void operator()(const f32x4 (&acc)[2][2][4][2], const Unit& u, int wr, int wc, int fr, int fq) const {
        const int row0 = u.pm * BM + wr * 64 + fr; const int colt = u.pn * BM + wc * 32 + 8 * fq;
#pragma unroll
        for (int ai = 0; ai < 2; ++ai)
#pragma unroll
            for (int m = 0; m < 4; ++m) { const size_t row = (size_t)(row0 + ai * HALF + m * 16);
#pragma unroll
                for (int bj = 0; bj < 2; ++bj) { const int col = colt + bj * HALF; const u32x4 gt = *(const u32x4*)(Zg + row * ZW + ZMB + col);
                    const f32x4 a0 = acc[ai][bj][m][0], a1 = acc[ai][bj][m][1];
                    u32x4 w; w.x = cvt_pk_bf16(a0[0] * gclamp(bflo(gt.x)), a0[1] * gclamp(bfhi(gt.x))); w.y = cvt_pk_bf16(a0[2] * gclamp(bflo(gt.y)), a0[3] * gclamp(bfhi(gt.y)));
                    w.z = cvt_pk_bf16(a1[0] * gclamp(bflo(gt.z)), a1[1] * gclamp(bfhi(gt.z))); w.w = cvt_pk_bf16(a1[2] * gclamp(bflo(gt.w)), a1[3] * gclamp(bfhi(gt.w)));
                    *(u32x4*)(Y + row * DM + col) = w; }
                if (m & 1) asm volatile("" ::: "memory"); }
    }
};
struct EpiRes {
    static constexpr bool PERM = true, AFTER_DRAIN = false, HAS_MID = false;
    const float* base; float* out; const float* gate;
    __device__ __forceinline__ void operator()(const f32x4 (&acc)[2][2][4][2], const Unit& u, int wr, int wc, int fr, int fq) const {
        const int row0 = u.pm * BM + wr * 64 + fr; const int colt = u.pn * BM + wc * 32 + 8 * fq; const int b = (u.pm * BM) >> 12;
        f32x4 bv[2][4];
#define ER_LOAD(buf, k_) do { const int bj_ = (k_) >> 2, ai_ = ((k_) >> 1) & 1, n_ = (k_) & 1; _Pragma("unroll") for (int m = 0; m < 4; ++m) bv[buf][m] = *(const f32x4*)(base + (size_t)(row0 + ai_ * HALF + m * 16) * DM + colt + bj_ * HALF + 4 * n_); } while (0)
        ER_LOAD(0, 0);
#pragma unroll
        for (int k = 0; k < 8; ++k) { const int bj = k >> 2, ai = (k >> 1) & 1, n = k & 1, cb = k & 1;
            if (k + 1 < 8) ER_LOAD(cb ^ 1, k + 1);
            const f32x4 g = *(const f32x4*)(gate + (size_t)b * 6144 + colt + bj * HALF + 4 * n);
            asm volatile("" ::: "memory");
#pragma unroll
            for (int m = 0; m < 4; ++m) *(f32x4*)(out + (size_t)(row0 + ai * HALF + m * 16) * DM + colt + bj * HALF + 4 * n) = bv[cb][m] + g * acc[ai][bj][m][n];
            asm volatile("" ::: "memory"); }
#undef ER_LOAD
    }
};
struct EpiRelu2 {
    static constexpr bool PERM = true, AFTER_DRAIN = false, HAS_MID = false;
    bf16_t* H;
    __device__ __forceinline__ void operator()(const f32x4 (&acc)[2][2][4][2], const Unit& u, int wr, int wc, int fr, int fq) const {
        const int row0 = u.pm * BM + wr * 64 + fr; const int colt = u.pn * BM + wc * 32 + 8 * fq;
#pragma unroll
        for (int ai = 0; ai < 2; ++ai)
#pragma unroll
            for (int m = 0; m < 4; ++m) { bf16_t* rowp = H + (size_t)(row0 + ai * HALF + m * 16) * FF + colt;
#pragma unroll
                for (int bj = 0; bj < 2; ++bj) { f32x4 v0 = acc[ai][bj][m][0], v1 = acc[ai][bj][m][1];
                    v0 = __builtin_elementwise_max(v0, (f32x4){0.f, 0.f, 0.f, 0.f}); v1 = __builtin_elementwise_max(v1, (f32x4){0.f, 0.f, 0.f, 0.f}); v0 = v0 * v0; v1 = v1 * v1;
                    u32x4 w; w.x = cvt_pk_bf16(v0[0], v0[1]); w.y = cvt_pk_bf16(v0[2], v0[3]); w.z = cvt_pk_bf16(v1[0], v1[1]); w.w = cvt_pk_bf16(v1[2], v1[3]);
                    *(u32x4*)(rowp + bj * HALF) = w; } }
    }
};
struct EpiRes2 {
    static constexpr bool PERM = true, AFTER_DRAIN = false, HAS_MID = false;
    const float* base; float* out; const float* gate; const float* g2; const float* scale2; bf16_t* XN2; float* rowss;
    __device__ __forceinline__ void operator()(const f32x4 (&acc)[2][2][4][2], const Unit& u, int wr, int wc, int fr, int fq) const {
        const int row0 = u.pm * BM + wr * 64 + fr; const int colt = u.pn * BM + wc * 32 + 8 * fq; const int b = (u.pm * BM) >> 12;
        float ss[8];
#pragma unroll
        for (int r = 0; r < 8; ++r) ss[r] = 0.f;
#pragma unroll
        for (int bj = 0; bj < 2; ++bj) { const int c = colt + bj * HALF;
            const f32x4 gt0 = *(const f32x4*)(gate + (size_t)b * 6144 + c), gt1 = *(const f32x4*)(gate + (size_t)b * 6144 + c + 4);
            const f32x4 gm0 = *(const f32x4*)(g2 + c) * (*(const f32x4*)(scale2 + (size_t)b * 6144 + c) + 1.0f), gm1 = *(const f32x4*)(g2 + c + 4) * (*(const f32x4*)(scale2 + (size_t)b * 6144 + c + 4) + 1.0f);
#pragma unroll
            for (int ai = 0; ai < 2; ++ai) {
                f32x4 bv[4][2];
#pragma unroll
                for (int m = 0; m < 4; ++m) { const size_t off = (size_t)(row0 + ai * HALF + m * 16) * DM + c; bv[m][0] = *(const f32x4*)(base + off); bv[m][1] = *(const f32x4*)(base + off + 4); }
                asm volatile("" ::: "memory");
#pragma unroll
                for (int m = 0; m < 4; ++m) { const size_t off = (size_t)(row0 + ai * HALF + m * 16) * DM + c;
                    const f32x4 h0 = bv[m][0] + gt0 * acc[ai][bj][m][0], h1 = bv[m][1] + gt1 * acc[ai][bj][m][1];
                    *(f32x4*)(out + off) = h0; *(f32x4*)(out + off + 4) = h1;
                    ss[ai * 4 + m] += (h0[0] * h0[0] + h0[1] * h0[1]) + (h0[2] * h0[2] + h0[3] * h0[3]) + (h1[0] * h1[0] + h1[1] * h1[1]) + (h1[2] * h1[2] + h1[3] * h1[3]);
                    const f32x4 v0 = h0 * gm0, v1 = h1 * gm1;
                    u32x4 w; w.x = cvt_pk_bf16(v0[0], v0[1]); w.y = cvt_pk_bf16(v0[2], v0[3]); w.z = cvt_pk_bf16(v1[0], v1[1]); w.w = cvt_pk_bf16(v1[2], v1[3]);
                    *(u32x4*)(XN2 + off) = w; }
                asm volatile("" ::: "memory"); } }
#pragma unroll
        for (int r = 0; r < 8; ++r) { float s = ss[r]; s += __shfl_xor(s, 16); s += __shfl_xor(s, 32);
            if (fq == 0) atomicAdd(rowss + row0 + (r >> 2) * HALF + (r & 3) * 16, s); }
    }
};
struct EpiRelu2N {
    static constexpr bool PERM = true, AFTER_DRAIN = false, HAS_MID = false;
    bf16_t* H; const float* rowss; const float* sw;
    __device__ __forceinline__ void operator()(const f32x4 (&acc)[2][2][4][2], const Unit& u, int wr, int wc, int fr, int fq) const {
        const int row0 = u.pm * BM + wr * 64 + fr; const int colt = u.pn * BM + wc * 32 + 8 * fq; const int b = (u.pm * BM) >> 12;
        float rstd[8];
#pragma unroll
        for (int r = 0; r < 8; ++r) rstd[r] = __builtin_amdgcn_rsqf(rowss[row0 + (r >> 2) * HALF + (r & 3) * 16] * (1.0f / DM) + 1e-6f);
#pragma unroll
        for (int bj = 0; bj < 2; ++bj) { const f32x4 sv0 = *(const f32x4*)(sw + (size_t)b * FF + colt + bj * HALF), sv1 = *(const f32x4*)(sw + (size_t)b * FF + colt + bj * HALF + 4);
#pragma unroll
            for (int ai = 0; ai < 2; ++ai)
#pragma unroll
                for (int m = 0; m < 4; ++m) { bf16_t* rowp = H + (size_t)(row0 + ai * HALF + m * 16) * FF + colt + bj * HALF;
                    f32x4 v0 = acc[ai][bj][m][0] * rstd[ai * 4 + m] + sv0, v1 = acc[ai][bj][m][1] * rstd[ai * 4 + m] + sv1;
                    v0 = __builtin_elementwise_max(v0, (f32x4){0.f, 0.f, 0.f, 0.f}); v1 = __builtin_elementwise_max(v1, (f32x4){0.f, 0.f, 0.f, 0.f}); v0 = v0 * v0; v1 = v1 * v1;
                    u32x4 w; w.x = cvt_pk_bf16(v0[0], v0[1]); w.y = cvt_pk_bf16(v0[2], v0[3]); w.z = cvt_pk_bf16(v1[0], v1[1]); w.w = cvt_pk_bf16(v1[2], v1[3]);
                    *(u32x4*)rowp = w; } }
    }
};
template <class Epi, class Sched, bool ALIGN_EPI = false, bool SP2 = false>
__device__ __forceinline__ void gemm_phase(PG8_LAS unsigned char* lds, const Gemm g, const Sched& S, const Epi& E) {
    int tid_ = threadIdx.x; asm volatile("" : "+v"(tid_));
    const int tid = tid_, wid = __builtin_amdgcn_readfirstlane(tid >> 6), lane = tid & 63, wr = wid >> 2, wc = wid & 3, fr = lane & 15, fq = lane >> 4;
    const int K = g.K, nt = K / BK;
    unsigned voffA[2], voffB[2];
#pragma unroll
    for (int i = 0; i < 2; ++i) { int R, C; stage_rc(tid * 16 + i * 8192, R, C); const int Rb = Epi::PERM ? ((R & ~31) + perm32(R & 31)) : R;
        voffA[i] = (unsigned)(R * K + C) * 2u; voffB[i] = (unsigned)(Rb * K + C) * 2u; }
    const size_t kstep = (size_t)(BK * 2);
    const size_t hstep = (size_t)HALF * K * 2;
    const size_t tstep = 2 * hstep;
    const unsigned ldsw = (unsigned)wid * 1024u;
    const int aoff = lds_byte(wr * 64 + fr, fq * 8), boff = lds_byte(wc * 32 + fr, fq * 8);
#define PG8_SA(b, h) (((b) * 2 + (h)) * HTB)
#define PG8_SB(b, h) ((4 + (b) * 2 + (h)) * HTB)
#define PG8_STAGE(bufoff, gbase, voff) do { _Pragma("unroll") for (int _i = 0; _i < 2; ++_i) \
        __builtin_amdgcn_global_load_lds((const unsigned*)((const char*)(gbase) + (voff)[_i]), (PG8_LAS unsigned*)(lds + (bufoff) + ldsw + _i * 8192), 16, 0, 0); } while (0)
#define PG8_LDA(dst, b, h) do { _Pragma("unroll") for (int m = 0; m < 4; ++m) _Pragma("unroll") for (int k = 0; k < 2; ++k) dst[m][k] = *(const PG8_LAS bf16x8*)(lds + PG8_SA(b, h) + aoff + m * 2048 + k * 1024); } while (0)
#define PG8_LDB(dst, b, h) do { _Pragma("unroll") for (int n = 0; n < 2; ++n) _Pragma("unroll") for (int k = 0; k < 2; ++k) dst[n][k] = *(const PG8_LAS bf16x8*)(lds + PG8_SB(b, h) + boff + n * 2048 + k * 1024); } while (0)
#define PG8_MMA(ai, bj, At, Bt) do { __builtin_amdgcn_s_setprio(1); _Pragma("unroll") for (int m = 0; m < 4; ++m) _Pragma("unroll") for (int n = 0; n < 2; ++n) _Pragma("unroll") for (int k = 0; k < 2; ++k) \
        acc[ai][bj][m][n] = __builtin_amdgcn_mfma_f32_16x16x32_bf16(Bt[n][k], At[m][k], acc[ai][bj][m][n], 0, 0, 0); __builtin_amdgcn_s_setprio(0); } while (0)
#define PG8_WAIT_V(n) asm volatile("s_waitcnt vmcnt(" #n ")" ::: "memory")
#define PG8_WAIT_L(n) asm volatile("s_waitcnt lgkmcnt(" #n ")" ::: "memory")
#define PG8_BAR __builtin_amdgcn_s_barrier()
#define PG8_SCHED __builtin_amdgcn_sched_barrier(0)
    Unit cur, nxt; int ui = 0;
    if (!S.next(0, cur)) return;
    f32x4 acc[2][2][4][2];
#pragma unroll
    for (int a = 0; a < 2; ++a)
#pragma unroll
        for (int b = 0; b < 2; ++b)
#pragma unroll
            for (int m = 0; m < 4; ++m)
#pragma unroll
                for (int n = 0; n < 2; ++n) acc[a][b][m][n] = (f32x4){0.f, 0.f, 0.f, 0.f};
    bf16x8 At[4][2], B0[2][2], B1[2][2];
    const char* cA = (const char*)g.A + (size_t)cur.pm * tstep; const char* cB = (const char*)g.Bt + (size_t)cur.pn * tstep;
    S.a_ready(cur);
    if constexpr (SP2) {
        PG8_STAGE(PG8_SB(0, 0), cB, voffB); PG8_STAGE(PG8_SB(0, 1), cB + hstep, voffB); PG8_STAGE(PG8_SA(0, 0), cA, voffA); PG8_STAGE(PG8_SA(0, 1), cA + hstep, voffA);
        if (wr == 1) PG8_BAR;
        PG8_WAIT_V(2); PG8_BAR;
        PG8_STAGE(PG8_SB(1, 0), cB + kstep, voffB); PG8_STAGE(PG8_SA(1, 0), cA + kstep, voffA); PG8_STAGE(PG8_SB(1, 1), cB + hstep + kstep, voffB);
        PG8_WAIT_V(6); PG8_BAR;
    } else {
        PG8_STAGE(PG8_SB(0, 0), cB, voffB); PG8_STAGE(PG8_SA(0, 0), cA, voffA); PG8_STAGE(PG8_SB(0, 1), cB + hstep, voffB); PG8_STAGE(PG8_SA(0, 1), cA + hstep, voffA);
        if (wr == 1) PG8_BAR;
        PG8_WAIT_V(4); PG8_BAR;
        PG8_STAGE(PG8_SB(1, 0), cB + kstep, voffB); PG8_STAGE(PG8_SA(1, 0), cA + kstep, voffA); PG8_STAGE(PG8_SB(1, 1), cB + hstep + kstep, voffB);
        PG8_WAIT_V(6); PG8_BAR;
    }
    for (;;) {
        const bool has_next = S.next(ui + 1, nxt);
        const char* nA = has_next ? (const char*)g.A + (size_t)nxt.pm * tstep : cA; const char* nB = has_next ? (const char*)g.Bt + (size_t)nxt.pn * tstep : cB;
        for (int t = 0; t < nt; t += 2) {
            if constexpr (Epi::HAS_MID) { if (t == nt / 2) E.mid(acc, cur, wr, wc, fr, fq); }
            const bool last = (t == nt - 2);
            const char* a1 = cA + (size_t)(t + 1) * kstep;
            const char* a2 = last ? nA : cA + (size_t)(t + 2) * kstep; const char* b2 = last ? nB : cB + (size_t)(t + 2) * kstep;
            const char* a3 = a2 + kstep; const char* b3 = b2 + kstep;
            if (last && has_next) S.a_ready(nxt);
            if constexpr (SP2) {
            PG8_LDB(B0, 0, 0); PG8_LDB(B1, 0, 1); PG8_SCHED; PG8_LDA(At, 0, 0); PG8_STAGE(PG8_SA(1, 1), a1 + hstep, voffA);
            PG8_WAIT_V(8); PG8_WAIT_L(0); PG8_BAR; PG8_MMA(0, 0, At, B0); PG8_MMA(0, 1, At, B1); PG8_BAR; PG8_SCHED;
            PG8_LDA(At, 0, 1); PG8_STAGE(PG8_SB(0, 0), b2, voffB); PG8_STAGE(PG8_SB(0, 1), b2 + hstep, voffB); PG8_STAGE(PG8_SA(0, 0), a2, voffA);
            PG8_WAIT_V(8); PG8_WAIT_L(0); PG8_BAR; PG8_MMA(1, 0, At, B0); PG8_MMA(1, 1, At, B1); PG8_BAR; PG8_SCHED;
            PG8_LDB(B0, 1, 0); PG8_LDB(B1, 1, 1); PG8_SCHED; PG8_LDA(At, 1, 0); PG8_STAGE(PG8_SA(0, 1), a2 + hstep, voffA);
            PG8_WAIT_V(8); PG8_WAIT_L(0); PG8_BAR; PG8_MMA(0, 0, At, B0); PG8_MMA(0, 1, At, B1); PG8_BAR; PG8_SCHED;
            PG8_LDA(At, 1, 1); PG8_STAGE(PG8_SB(1, 0), b3, voffB); PG8_STAGE(PG8_SB(1, 1), b3 + hstep, voffB); PG8_STAGE(PG8_SA(1, 0), a3, voffA);
            PG8_WAIT_V(8); PG8_WAIT_L(0); PG8_BAR; PG8_MMA(1, 0, At, B0); PG8_MMA(1, 1, At, B1); PG8_BAR; PG8_SCHED;
            } else {
            PG8_LDB(B0, 0, 0); PG8_SCHED; PG8_LDA(At, 0, 0); PG8_STAGE(PG8_SA(1, 1), a1 + hstep, voffA);
            PG8_WAIT_L(8); PG8_BAR; PG8_WAIT_L(0); PG8_MMA(0, 0, At, B0); PG8_BAR; PG8_SCHED;
            PG8_LDB(B1, 0, 1); PG8_STAGE(PG8_SB(0, 0), b2, voffB);
            PG8_BAR; PG8_WAIT_L(0); PG8_MMA(0, 1, At, B1); PG8_BAR;
            PG8_LDA(At, 0, 1); PG8_STAGE(PG8_SA(0, 0), a2, voffA);
            PG8_BAR; PG8_WAIT_L(0); PG8_MMA(1, 0, At, B0); PG8_BAR; PG8_SCHED;
            PG8_STAGE(PG8_SB(0, 1), b2 + hstep, voffB);
            PG8_WAIT_V(6); PG8_BAR; PG8_MMA(1, 1, At, B1); PG8_BAR;
            PG8_LDB(B0, 1, 0); PG8_SCHED; PG8_LDA(At, 1, 0); PG8_STAGE(PG8_SA(0, 1), a2 + hstep, voffA);
            PG8_WAIT_L(8); PG8_BAR; PG8_WAIT_L(0); PG8_MMA(0, 0, At, B0); PG8_BAR; PG8_SCHED;
            PG8_LDB(B1, 1, 1); PG8_STAGE(PG8_SB(1, 0), b3, voffB);
            PG8_BAR; PG8_WAIT_L(0); PG8_MMA(0, 1, At, B1); PG8_BAR;
            PG8_LDA(At, 1, 1); PG8_STAGE(PG8_SA(1, 0), a3, voffA);
            PG8_BAR; PG8_WAIT_L(0); PG8_MMA(1, 0, At, B0); PG8_BAR; PG8_SCHED;
            PG8_STAGE(PG8_SB(1, 1), b3 + hstep, voffB);
            PG8_WAIT_V(6); PG8_BAR; PG8_MMA(1, 1, At, B1); PG8_BAR;
            }
        }
        if constexpr (ALIGN_EPI) { if (wr == 0) PG8_BAR; }
        if constexpr (!Epi::AFTER_DRAIN) { E(acc, cur, wr, wc, fr, fq); S.done(cur); }
        if (!has_next) break;
#pragma unroll
        for (int a = 0; a < 2; ++a)
#pragma unroll
            for (int b = 0; b < 2; ++b)
#pragma unroll
                for (int m = 0; m < 4; ++m)
#pragma unroll
                    for (int n = 0; n < 2; ++n) acc[a][b][m][n] = (f32x4){0.f, 0.f, 0.f, 0.f};
        cur = nxt; cA = nA; cB = nB; ++ui;
        if constexpr (ALIGN_EPI) { if (wr == 1) PG8_BAR; }
    }
    PG8_WAIT_V(0);
    if constexpr (!ALIGN_EPI) { if (wr == 0) PG8_BAR; }
    PG8_BAR;
    if constexpr (Epi::AFTER_DRAIN) { E.fused(acc, cur, wr, wc, fr, fq, lds, wid, lane); S.done(cur); }
#undef PG8_SA
#undef PG8_SB
#undef PG8_STAGE
#undef PG8_LDA
#undef PG8_LDB
#undef PG8_MMA
#undef PG8_WAIT_V
#undef PG8_WAIT_L
#undef PG8_BAR
#undef PG8_SCHED
}
}

#define LAS __attribute__((address_space(3)))
typedef unsigned short bf16;
typedef unsigned v4u __attribute__((ext_vector_type(4)));
typedef unsigned v2u __attribute__((ext_vector_type(2)));
typedef float f32x4 __attribute__((ext_vector_type(4)));
typedef float f32x16 __attribute__((ext_vector_type(16)));
typedef short bf16x8 __attribute__((ext_vector_type(8)));
typedef float f32x2_t __attribute__((ext_vector_type(2)));
typedef __bf16 bf16x2_t __attribute__((ext_vector_type(2)));
#define LDS_WAIT() asm volatile("s_waitcnt lgkmcnt(0)" ::: "memory")
constexpr int LDS_BYTES = 147456;
constexpr int NWAVES = 8;

struct Params { const float* in[20]; float* out; unsigned char* ws; };

__device__ __forceinline__ unsigned pk2(float lo, float hi) { f32x2_t v = {lo, hi}; bf16x2_t b = __builtin_convertvector(v, bf16x2_t); return __builtin_bit_cast(unsigned, b); }
__device__ __forceinline__ float bflo(unsigned u) { return __uint_as_float(u << 16); }
__device__ __forceinline__ float bfhi(unsigned u) { return __uint_as_float(u & 0xffff0000u); }
__device__ __forceinline__ float ex2(float x) { return __builtin_amdgcn_exp2f(x); }
__device__ __forceinline__ float lg2(float x) { return __builtin_amdgcn_logf(x); }
__device__ __forceinline__ float rcp(float x) { return __builtin_amdgcn_rcpf(x); }
__device__ __forceinline__ float sigm(float x) { return rcp(1.0f + ex2(-LOG2E * x)); }
__device__ __forceinline__ float wave_sum(float v) {
#pragma unroll
    for (int o = 1; o < 64; o <<= 1) v += __shfl_xor(v, o);
    return v;
}

__device__ __forceinline__ void transpose_item(const float* W, int ldw, int K, int ncols, bf16* WT, int row_off, LAS float* scr, int item, int lane) {
    const int nblk = ncols / 32, kb = item / nblk, nb = item % nblk, k0 = 64 * kb, n0 = 32 * nb;
    float tv[32];
#pragma unroll
    for (int i = 0; i < 32; ++i) { const int kk = 2 * i + (lane >> 5); tv[i] = W[(size_t)(k0 + kk) * ldw + n0 + (lane & 31)]; }
#pragma unroll
    for (int i = 0; i < 32; ++i) { const int kk = 2 * i + (lane >> 5); scr[kk * 33 + (lane & 31)] = tv[i]; }
    LDS_WAIT();
    const int c = lane & 7;
#pragma unroll
    for (int j = 0; j < 4; ++j) { const int n = (lane >> 3) + 8 * j; const LAS float* s = scr + (8 * c) * 33 + n;
        v4u o; o.x = pk2(s[0 * 33], s[1 * 33]); o.y = pk2(s[2 * 33], s[3 * 33]); o.z = pk2(s[4 * 33], s[5 * 33]); o.w = pk2(s[6 * 33], s[7 * 33]);
        *(v4u*)(WT + (size_t)(row_off + n0 + n) * K + k0 + 8 * c) = o; }
    LDS_WAIT();
}

__device__ __forceinline__ void transpose_item_kp(const float* W, int ldw, int K, int ncols, bf16* WT, int dpitch, int koff, LAS float* scr, int item, int lane) {
    const int nblk = ncols / 32, kb = item / nblk, nb = item % nblk, k0 = 64 * kb, n0 = 32 * nb;
    float tv[32];
#pragma unroll
    for (int i = 0; i < 32; ++i) { const int kk = 2 * i + (lane >> 5); tv[i] = W[(size_t)(k0 + kk) * ldw + n0 + (lane & 31)]; }
#pragma unroll
    for (int i = 0; i < 32; ++i) { const int kk = 2 * i + (lane >> 5); scr[kk * 33 + (lane & 31)] = tv[i]; }
    LDS_WAIT();
    const int c = lane & 7;
#pragma unroll
    for (int j = 0; j < 4; ++j) { const int n = (lane >> 3) + 8 * j; const LAS float* s = scr + (8 * c) * 33 + n;
        v4u o; o.x = pk2(s[0 * 33], s[1 * 33]); o.y = pk2(s[2 * 33], s[3 * 33]); o.z = pk2(s[4 * 33], s[5 * 33]); o.w = pk2(s[6 * 33], s[7 * 33]);
        *(v4u*)(WT + (size_t)(n0 + n) * dpitch + koff + k0 + 8 * c) = o; }
    LDS_WAIT();
}

__device__ __forceinline__ void phase0(const Params& p, LAS unsigned char* lds, int tid, int lane, int wave) {
    unsigned char* ws = p.ws;
    { float* rowss = (float*)(ws + WS_ROWSS); for (int e = blockIdx.x * 512 + tid; e < M; e += gridDim.x * 512) rowss[e] = 0.f; }
    LAS float* scr = (LAS float*)(lds + wave * 16384);
    const int gw = blockIdx.x * NWAVES + wave, NGW = gridDim.x * NWAVES;
    const float* w_in = p.in[7];
    bf16* Win_t = (bf16*)(ws + WS_WIN);
    constexpr int I0 = 16 * 40, I1 = 16 * 48, I2 = 16 * 32, I3 = 16 * 32, I4 = 8 * 32, I5 = 8 * 32, I6 = 16 * 32, I7 = 16 * 128, I8 = 64 * 32, I9 = 32 * 2, I10 = 32 * 2;
    constexpr int NITEMS = I0 + I1 + I2 + I3 + I4 + I5 + I6 + I7 + I8 + I9 + I10;
    for (int it = gw; it < NITEMS; it += NGW) {
        int r = it;
        if (r < I0) { transpose_item(w_in, 4888, DM, 1280, Win_t, 0, scr, r, lane); continue; } r -= I0;
        if (r < I1) { transpose_item(w_in + 1304, 4888, DM, 1536, Win_t, 1280, scr, r, lane); continue; } r -= I1;
        if (r < I2) { transpose_item(w_in + 2840, 4888, DM, 1024, Win_t, 2816, scr, r, lane); continue; } r -= I2;
        if (r < I3) { transpose_item(w_in + 3864, 4888, DM, 1024, Win_t, 3840, scr, r, lane); continue; } r -= I3;
        if (r < I4) { transpose_item_kp(p.in[15], DM, 512, DM, (bf16*)(ws + WS_WUPA), DM, 0, scr, r, lane); continue; } r -= I4;
        if (r < I5) { transpose_item_kp(p.in[16], DM, 512, DM, (bf16*)(ws + WS_WUPA), DM, 512, scr, r, lane); continue; } r -= I5;
        if (r < I6) { transpose_item(p.in[17], DM, DM, DM, (bf16*)(ws + WS_WOUT), 0, scr, r, lane); continue; } r -= I6;
        if (r < I7) { transpose_item(p.in[18], FF, DM, FF, (bf16*)(ws + WS_W1), 0, scr, r, lane); continue; } r -= I7;
        if (r < I8) { transpose_item(p.in[19], DM, FF, DM, (bf16*)(ws + WS_W2), 0, scr, r, lane); continue; } r -= I8;
        if (r < I9) { transpose_item(p.in[9], 64, 2048, 64, (bf16*)(ws + WS_CW1K), 0, scr, r, lane); continue; } r -= I9;
        transpose_item(p.in[11], 64, 2048, 64, (bf16*)(ws + WS_CW1V), 0, scr, r, lane);
    }
    __syncthreads();
    LAS float* sc = (LAS float*)lds;
    LAS float* red = (LAS float*)(lds + 65536);
    float* mod = (float*)(ws + WS_MOD);
    for (int it = blockIdx.x; it < 247; it += gridDim.x) {
        if (it < 192) {
            const float* c = p.in[1]; const float* ada_w = p.in[3]; const float* ada_b = p.in[4];
            for (int e = tid; e < 16384; e += 512) { const float v = c[e]; sc[e] = v * sigm(v); }
            __syncthreads();
            const int colj = tid & 31, kg = tid >> 5, j0 = it * 32;
            float acc[16];
#pragma unroll
            for (int b = 0; b < 16; ++b) acc[b] = 0.f;
            for (int k8 = kg * 64; k8 < kg * 64 + 64; k8 += 8) {
                float w[8];
#pragma unroll
                for (int u = 0; u < 8; ++u) w[u] = ada_w[(size_t)(k8 + u) * 6144 + j0 + colj];
#pragma unroll
                for (int u = 0; u < 8; ++u)
#pragma unroll
                    for (int b = 0; b < 16; ++b) acc[b] += sc[b * 1024 + k8 + u] * w[u];
            }
#pragma unroll
            for (int b = 0; b < 16; ++b) red[(kg * 16 + b) * 32 + colj] = acc[b];
            __syncthreads();
            { const int b = tid >> 5, cj = tid & 31; float s = ada_b[j0 + cj];
#pragma unroll
              for (int k2 = 0; k2 < 16; ++k2) s += red[(k2 * 16 + b) * 32 + cj];
              mod[b * 6144 + j0 + cj] = s; }
            __syncthreads();
        } else if (it < 194) {
            const int kv = it - 192; const float* w1 = kv ? p.in[11] : p.in[9]; const float* pos = p.in[8];
            const int colj = tid & 63, kg = tid >> 6; float a = 0.f;
            for (int k16 = kg * 256; k16 < kg * 256 + 256; k16 += 16) {
                float w[16], pv_[16];
#pragma unroll
                for (int u = 0; u < 16; ++u) { w[u] = w1[(k16 + u) * 64 + colj]; pv_[u] = pos[k16 + u]; }
#pragma unroll
                for (int u = 0; u < 16; ++u) a += pv_[u] * w[u];
            }
            red[kg * 64 + colj] = a;
            __syncthreads();
            if (tid < 64) { float s = 0.f;
#pragma unroll
                for (int k2 = 0; k2 < 8; ++k2) s += red[k2 * 64 + tid];
                ((float*)(ws + WS_PW1))[kv * 64 + tid] = s; }
            __syncthreads();
        } else if (it < 218) {
            const int r = it - 194;
            for (int k = tid; k < 1024; k += 512) Win_t[(size_t)(4864 + r) * 1024 + k] = (bf16)(pk2(w_in[(size_t)k * 4888 + 1280 + r], 0.f) & 0xffffu);
        } else {
            v4u* zp = (v4u*)(Win_t + (size_t)(4888 + 8 * (it - 218)) * 1024);
            for (int e = tid; e < 8 * 1024 / 8; e += 512) zp[e] = (v4u){0u, 0u, 0u, 0u};
        }
    }
}

__device__ __forceinline__ void norm_rows(const float* src, const float* gain, const float* mod, int shift_off, int scale_off, bf16* dst, int lane, int wave) {
    const int gw = blockIdx.x * NWAVES + wave, NGW = gridDim.x * NWAVES;
    const int rpw = (M + NGW - 1) / NGW;
    const int m0 = gw * rpw, m1 = (m0 + rpw < M) ? m0 + rpw : M;
    if (m0 >= M) return;
    f32x4 gam[4], sh[4];
    int bcur = -1;
    f32x4 v[4], nx[4];
    { const f32x4* xr = (const f32x4*)(src + (size_t)m0 * DM) + lane;
#pragma unroll
      for (int j = 0; j < 4; ++j) nx[j] = xr[64 * j]; }
    for (int m = m0; m < m1; ++m) {
        const int b = m >> 12;
        if (b != bcur) { bcur = b;
#pragma unroll
            for (int j = 0; j < 4; ++j) { const int col = 4 * (lane + 64 * j);
                const f32x4 g = *(const f32x4*)(gain + col), sc = *(const f32x4*)(mod + b * 6144 + scale_off + col); sh[j] = *(const f32x4*)(mod + b * 6144 + shift_off + col);
                gam[j] = g * (sc + 1.0f); } }
#pragma unroll
        for (int j = 0; j < 4; ++j) v[j] = nx[j];
        if (m + 1 < m1) { const f32x4* xr = (const f32x4*)(src + (size_t)(m + 1) * DM) + lane;
#pragma unroll
            for (int j = 0; j < 4; ++j) nx[j] = xr[64 * j]; }
        float ss = 0.f;
#pragma unroll
        for (int j = 0; j < 4; ++j) ss += (v[j].x * v[j].x + v[j].y * v[j].y) + (v[j].z * v[j].z + v[j].w * v[j].w);
        const float rstd = rsqrtf(wave_sum(ss) * (1.0f / DM) + 1e-6f);
#pragma unroll
        for (int j = 0; j < 4; ++j) { const int col = 4 * (lane + 64 * j);
            const f32x4 u = (v[j] * rstd) * gam[j] + sh[j];
            v2u w; w.x = pk2(u.x, u.y); w.y = pk2(u.z, u.w);
            *(v2u*)(dst + (size_t)m * DM + col) = w; }
    }
}

__device__ __forceinline__ void phase3(const Params& p, LAS unsigned char* lds, int tid, int lane, int wave, bool do_norm) {
    unsigned char* ws = p.ws;
    bf16* Z = (bf16*)(ws + WS_Z);
    const int gw = blockIdx.x * NWAVES + wave, NGW = gridDim.x * NWAVES;
    {
        LAS float* hid = (LAS float*)(lds + wave * 4352);
        const int row = lane & 15, quad = lane >> 4;
        for (int task = (NGW - 1 - gw); task < 1024; task += NGW) {
            const int kv = task & 1, cg16 = (task >> 1) & 15, hkv = (task >> 5) & 1, b = task >> 6;
            const int c0 = cg16 * 16;
            const bf16* w1t = (const bf16*)(ws + (kv ? WS_CW1V : WS_CW1K));
            const float* pw1 = (const float*)(ws + WS_PW1) + kv * 64;
            const float* w2 = kv ? p.in[12] : p.in[10];
            const int zc = (kv ? ZVC : ZKC) + hkv * 64;
            int t0 = 16 * (c0 + row);
            f32x4 acc[4];
#pragma unroll
            for (int nt = 0; nt < 4; ++nt) acc[nt] = (f32x4){0.f, 0.f, 0.f, 0.f};
#pragma unroll 8
            for (int s = 0; s < 64; ++s) {
                int tk = t0 + (s >> 1); tk = tk < S ? tk : S - 1;
                const bf16x8 a = *(const bf16x8*)(Z + ((size_t)b * S + tk) * ZW + zc + (s & 1) * 32 + quad * 8);
#pragma unroll
                for (int nt = 0; nt < 4; ++nt) { const bf16x8 bb = *(const bf16x8*)(w1t + (size_t)(nt * 16 + row) * 2048 + s * 32 + quad * 8);
                    acc[nt] = __builtin_amdgcn_mfma_f32_16x16x32_bf16(a, bb, acc[nt], 0, 0, 0); }
            }
#pragma unroll
            for (int nt = 0; nt < 4; ++nt) { const float pb = pw1[nt * 16 + row];
#pragma unroll
                for (int j = 0; j < 4; ++j) { const float x = acc[nt][j] + pb; hid[(quad * 4 + j) * 68 + nt * 16 + row] = x * sigm(x); } }
            LDS_WAIT();
            float o[16];
#pragma unroll
            for (int r = 0; r < 16; ++r) o[r] = 0.f;
            for (int k = 0; k < 64; k += 4) {
                const float wa = w2[(k + 0) * 64 + lane], wb = w2[(k + 1) * 64 + lane], wc_ = w2[(k + 2) * 64 + lane], wd = w2[(k + 3) * 64 + lane];
#pragma unroll
                for (int r = 0; r < 16; ++r) { const f32x4 h = *(const LAS f32x4*)(hid + r * 68 + k); o[r] += h.x * wa + h.y * wb + h.z * wc_ + h.w * wd; }
            }
            LDS_WAIT();
            if (kv == 0) {
                const float gn = p.in[14][lane];
                bf16* KC = (bf16*)(ws + WS_KC) + ((size_t)(b * 2 + hkv) * 256 + c0) * 64 + lane;
#pragma unroll
                for (int r = 0; r < 16; ++r) { const float ss = wave_sum(o[r] * o[r]); const float rstd = rsqrtf(ss * (1.0f / 64.0f) + 1e-6f);
                    const float v = (c0 + r < 255) ? o[r] * rstd * gn : 0.f; KC[r * 64] = (bf16)(pk2(v, 0.f) & 0xffffu); }
            } else {
                bf16* VCT = (bf16*)(ws + WS_VCT) + ((size_t)(b * 2 + hkv) * 64 + lane) * 256 + c0;
                if (c0 + 15 >= 255) o[15] = 0.f;
                v4u w0, w1;
                w0.x = pk2(o[0], o[1]); w0.y = pk2(o[2], o[3]); w0.z = pk2(o[8], o[9]); w0.w = pk2(o[10], o[11]);
                w1.x = pk2(o[4], o[5]); w1.y = pk2(o[6], o[7]); w1.z = pk2(o[12], o[13]); w1.w = pk2(o[14], o[15]);
                *(v4u*)VCT = w0; *(v4u*)(VCT + 8) = w1;
            }
        }
    }
    __syncthreads();
    if (do_norm) {
        const float* qg = p.in[13]; const float* kg = p.in[14];
        const int sub = lane & 7;
        const long total = (long)M * 12;
        if (gw < NGW / 2)
        for (long base = (long)gw * 32; base < total; base += (long)(NGW / 2) * 32) {
            v4u raw[4]; v4u* ptr[4]; const float* gnp[4]; float extra[4];
#pragma unroll
            for (int u = 0; u < 4; ++u) {
                const long vi = base + u * 8 + (lane >> 3);
                const int tokn = (int)(vi / 12), which = (int)(vi - (long)tokn * 12);
                int col; extra[u] = 1.0f;
                if (which < 8) { col = ZQ + which * 64; gnp[u] = qg; extra[u] = 0.125f * LOG2E; }
                else if (which < 10) { col = ZKS + (which - 8) * 64; gnp[u] = kg + 64; }
                else { col = ZKW + (which - 10) * 64; gnp[u] = kg + 128; }
                ptr[u] = (v4u*)(Z + (size_t)tokn * ZW + col + sub * 8);
                raw[u] = *ptr[u];
            }
#pragma unroll
            for (int u = 0; u < 4; ++u) {
                const v4u rw = raw[u];
                float f[8] = {bflo(rw.x), bfhi(rw.x), bflo(rw.y), bfhi(rw.y), bflo(rw.z), bfhi(rw.z), bflo(rw.w), bfhi(rw.w)};
                float ss = 0.f;
#pragma unroll
                for (int e2 = 0; e2 < 8; ++e2) ss += f[e2] * f[e2];
                ss += __shfl_xor(ss, 1); ss += __shfl_xor(ss, 2); ss += __shfl_xor(ss, 4);
                const float rstd = rsqrtf(ss * (1.0f / 64.0f) + 1e-6f) * extra[u];
                const f32x4 g0 = *(const f32x4*)(gnp[u] + sub * 8), g1 = *(const f32x4*)(gnp[u] + sub * 8 + 4);
                v4u o; o.x = pk2(f[0] * rstd * g0.x, f[1] * rstd * g0.y); o.y = pk2(f[2] * rstd * g0.z, f[3] * rstd * g0.w);
                o.z = pk2(f[4] * rstd * g1.x, f[5] * rstd * g1.y); o.w = pk2(f[6] * rstd * g1.z, f[7] * rstd * g1.w);
                *ptr[u] = o;
            }
        }
    }
    __syncthreads();
    { LAS float* shl = (LAS float*)lds; const float* mod = (const float*)(ws + WS_MOD); const bf16* W1t = (const bf16*)(ws + WS_W1); float* sw = (float*)(ws + WS_SW);
      for (int e = tid; e < 16384; e += 512) shl[e] = mod[(e >> 10) * 6144 + 3072 + (e & 1023)];
      __syncthreads();
      for (int colx = gw; colx < FF; colx += NGW) {
          const v4u wa = *(const v4u*)(W1t + (size_t)colx * DM + lane * 16), wb = *(const v4u*)(W1t + (size_t)colx * DM + lane * 16 + 8);
          const float wv[16] = {bflo(wa.x), bfhi(wa.x), bflo(wa.y), bfhi(wa.y), bflo(wa.z), bfhi(wa.z), bflo(wa.w), bfhi(wa.w), bflo(wb.x), bfhi(wb.x), bflo(wb.y), bfhi(wb.y), bflo(wb.z), bfhi(wb.z), bflo(wb.w), bfhi(wb.w)};
          float res = 0.f;
#pragma unroll 1
          for (int bb = 0; bb < 16; ++bb) { float a = 0.f;
#pragma unroll
              for (int e4 = 0; e4 < 4; ++e4) { const f32x4 s4 = *(const LAS f32x4*)(shl + bb * 1024 + lane * 16 + e4 * 4); a += s4.x * wv[4 * e4] + s4.y * wv[4 * e4 + 1] + s4.z * wv[4 * e4 + 2] + s4.w * wv[4 * e4 + 3]; }
              a = wave_sum(a); if (lane == bb) res = a; }
          if (lane < 16) sw[(size_t)lane * FF + colx] = res;
      } }
}

constexpr int NSTG = 4, STG_BYTES = 16384, LUT_OFF = 65536, ACC_OFF = 69632, MISC4_OFF = 135168, LUT2_OFF = 137728;
#define MFMA32(a, b, c) __builtin_amdgcn_mfma_f32_32x32x16_bf16((a), (b), (c), 0, 0, 0)
#define KKOF(hf, r) (32 * (hf) + ((r) & 3) + 8 * ((r) >> 2))
constexpr float NEGBIG = -1.0e30f;

__device__ __forceinline__ void glds16(const void* gsrc, unsigned lds_dst) {
    unsigned keep;
    asm volatile("s_mov_b32 %0, m0\n\ts_mov_b32 m0, %2\n\ts_nop 0\n\tglobal_load_lds_dwordx4 %1, off\n\ts_mov_b32 m0, %0" : "=&s"(keep) : "v"(gsrc), "s"(lds_dst) : "memory");
}
#define WAITV_BAR(N) asm volatile("s_waitcnt vmcnt(" #N ")\n\ts_barrier" ::: "memory")
#define RING_WAIT(ahead) do { if ((ahead) >= 2) WAITV_BAR(4); else if ((ahead) == 1) WAITV_BAR(2); else WAITV_BAR(0); } while (0)
#define RING_WAIT4(ahead) do { if ((ahead) >= 2) WAITV_BAR(8); else if ((ahead) == 1) WAITV_BAR(4); else WAITV_BAR(0); } while (0)
#define RING_DRAIN() asm volatile("s_waitcnt vmcnt(0)" ::: "memory")

struct Ring {
    int r8, c8; unsigned base;
    __device__ __forceinline__ void init(LAS unsigned char* lds, int lane, int wave) { r8 = 8 * wave + (lane >> 3); c8 = (lane & 7) ^ ((lane >> 3) & 7); base = (unsigned)(uintptr_t)lds + (unsigned)wave * 1024u; }
    __device__ __forceinline__ void issue4(const bf16* k, const bf16* v, size_t pitch, int stage) const {
        const size_t o = (size_t)r8 * pitch + c8 * 8; const unsigned d = base + (unsigned)stage * (2u * STG_BYTES);
        glds16(k + o, (unsigned)__builtin_amdgcn_readfirstlane(d));
        glds16(v + o, (unsigned)__builtin_amdgcn_readfirstlane(d + 8192u));
        glds16(k + o + 64, (unsigned)__builtin_amdgcn_readfirstlane(d + 16384u));
        glds16(v + o + 64, (unsigned)__builtin_amdgcn_readfirstlane(d + 24576u));
    }
    __device__ __forceinline__ void issue(const bf16* k, size_t kpitch, const bf16* vt, size_t vpitch, int stage) const {
        glds16(k + (size_t)r8 * kpitch + c8 * 8, (unsigned)__builtin_amdgcn_readfirstlane(base + (unsigned)stage * STG_BYTES));
        glds16(vt + (size_t)r8 * vpitch + c8 * 8, (unsigned)__builtin_amdgcn_readfirstlane(base + (unsigned)stage * STG_BYTES + 8192u));
    }
};

__device__ __forceinline__ void qk_tile(const LAS unsigned char* kb, const bf16x8 (&qf)[4], int col, int hi, f32x16& s0, f32x16& s1, float cinit) {
    const LAS unsigned char* k0 = kb + col * 128; const int k7 = col & 7;
    bf16x8 a0[4], a1[4];
#pragma unroll
    for (int d0 = 0; d0 < 4; ++d0) { const int off = ((2 * d0 + hi) ^ k7) << 4; a0[d0] = *(const LAS bf16x8*)(k0 + off); a1[d0] = *(const LAS bf16x8*)(k0 + 32 * 128 + off); }
    asm volatile("" ::: "memory");
    f32x16 c;
#pragma unroll
    for (int r = 0; r < 16; ++r) c[r] = cinit;
    s0 = MFMA32(a0[0], qf[0], c); s1 = MFMA32(a1[0], qf[0], c);
#pragma unroll
    for (int d0 = 1; d0 < 4; ++d0) { s0 = MFMA32(a0[d0], qf[d0], s0); s1 = MFMA32(a1[d0], qf[d0], s1); }
}
__device__ __forceinline__ void qk_half_c(const LAS unsigned char* kb, const bf16x8 (&qf)[4], int col, int hi, int hf, f32x16& s, const f32x16& c) {
    const LAS unsigned char* k0 = kb + (32 * hf + col) * 128; const int k7 = col & 7;
    bf16x8 a[4];
#pragma unroll
    for (int d0 = 0; d0 < 4; ++d0) a[d0] = *(const LAS bf16x8*)(k0 + (((2 * d0 + hi) ^ k7) << 4));
    asm volatile("" ::: "memory");
    s = MFMA32(a[0], qf[0], c);
#pragma unroll
    for (int d0 = 1; d0 < 4; ++d0) s = MFMA32(a[d0], qf[d0], s);
}
__device__ __forceinline__ void qk_half(const LAS unsigned char* kb, const bf16x8 (&qf)[4], int col, int hi, int hf, f32x16& s, float cinit) {
    f32x16 c;
#pragma unroll
    for (int r = 0; r < 16; ++r) c[r] = cinit;
    qk_half_c(kb, qf, col, hi, hf, s, c);
}
__device__ __forceinline__ void pv_half(const LAS unsigned char* vb, const unsigned (&pw)[8], int col, int hi, int hf, f32x16& o0, f32x16& o1, f32x16& os, bf16x8 ones) {
    const LAS unsigned char* v0 = vb + col * 128; const int k7 = col & 7;
    bf16x8 a[2], bq[2];
#pragma unroll
    for (int s2 = 0; s2 < 2; ++s2) { const int e = ((2 * (2 * hf + s2) + hi) ^ k7) << 4; a[s2] = *(const LAS bf16x8*)(v0 + e); bq[s2] = *(const LAS bf16x8*)(v0 + 32 * 128 + e); }
    asm volatile("" ::: "memory");
#pragma unroll
    for (int s2 = 0; s2 < 2; ++s2) {
        const v4u pu = {pw[4 * s2], pw[4 * s2 + 1], pw[4 * s2 + 2], pw[4 * s2 + 3]};
        const bf16x8 pf = __builtin_bit_cast(bf16x8, pu);
        o0 = MFMA32(a[s2], pf, o0);
        o1 = MFMA32(bq[s2], pf, o1);
        os = MFMA32(ones, pf, os);
    }
}
__device__ __forceinline__ void pv_tile(const LAS unsigned char* vb, const unsigned (&pw)[16], int col, int hi, f32x16& o0, f32x16& o1) {
    const LAS unsigned char* v0 = vb + col * 128; const int k7 = col & 7;
#pragma unroll
    for (int sl = 0; sl < 4; ++sl) {
        const v4u pu = {pw[4 * sl], pw[4 * sl + 1], pw[4 * sl + 2], pw[4 * sl + 3]};
        const bf16x8 pf = __builtin_bit_cast(bf16x8, pu);
        const int e = ((2 * sl + hi) ^ k7) << 4;
        const bf16x8 a = *(const LAS bf16x8*)(v0 + e), bq = *(const LAS bf16x8*)(v0 + 32 * 128 + e);
        o0 = MFMA32(a, pf, o0);
        o1 = MFMA32(bq, pf, o1);
    }
}
typedef short v4i16_t __attribute__((ext_vector_type(4)));
__device__ __forceinline__ v2u vtr8(const LAS unsigned char* p) { return __builtin_bit_cast(v2u, __builtin_amdgcn_ds_read_tr16_b64_v4i16((LAS v4i16_t*)p)); }
struct TrAddr { int base0, ch0, ch1; };
__device__ __forceinline__ TrAddr tr_addr(int lane) {
    const int h = lane >> 5, blk = (lane >> 4) & 1, q = (lane & 15) >> 2, pp = lane & 3, r7 = 4 * h + q;
    TrAddr a; a.base0 = r7 * 128 + 8 * (pp & 1); a.ch0 = ((2 * blk + (pp >> 1)) ^ r7) << 4; a.ch1 = ((4 + 2 * blk + (pp >> 1)) ^ r7) << 4; return a;
}
__device__ __forceinline__ void pv_half_tr(const LAS unsigned char* vb, const unsigned (&pw)[8], const TrAddr& ta, int hf, f32x16& o0, f32x16& o1, f32x16& os, bf16x8 ones) {
    const LAS unsigned char* v0 = vb + ta.base0;
    v2u a0[2], a1[2], b0[2], b1[2];
#pragma unroll
    for (int s2 = 0; s2 < 2; ++s2) { const int ro = (2 * hf + s2) * 2048;
        a0[s2] = vtr8(v0 + ro + ta.ch0); a1[s2] = vtr8(v0 + ro + 1024 + ta.ch0); b0[s2] = vtr8(v0 + ro + ta.ch1); b1[s2] = vtr8(v0 + ro + 1024 + ta.ch1); }
#pragma unroll
    for (int s2 = 0; s2 < 2; ++s2) {
        const v4u pu = {pw[4 * s2], pw[4 * s2 + 1], pw[4 * s2 + 2], pw[4 * s2 + 3]};
        const bf16x8 pf = __builtin_bit_cast(bf16x8, pu);
        const v4u au = {a0[s2].x, a0[s2].y, a1[s2].x, a1[s2].y}, bu = {b0[s2].x, b0[s2].y, b1[s2].x, b1[s2].y};
        o0 = MFMA32(__builtin_bit_cast(bf16x8, au), pf, o0);
        o1 = MFMA32(__builtin_bit_cast(bf16x8, bu), pf, o1);
        os = MFMA32(ones, pf, os);
    }
}
__device__ __forceinline__ void pv_tile_tr(const LAS unsigned char* vb, const unsigned (&pw)[16], const TrAddr& ta, f32x16& o0, f32x16& o1) {
    const LAS unsigned char* v0 = vb + ta.base0;
#pragma unroll
    for (int sl = 0; sl < 4; ++sl) {
        const v4u pu = {pw[4 * sl], pw[4 * sl + 1], pw[4 * sl + 2], pw[4 * sl + 3]};
        const bf16x8 pf = __builtin_bit_cast(bf16x8, pu);
        const v2u a0 = vtr8(v0 + sl * 2048 + ta.ch0), a1 = vtr8(v0 + sl * 2048 + 1024 + ta.ch0), b0 = vtr8(v0 + sl * 2048 + ta.ch1), b1 = vtr8(v0 + sl * 2048 + 1024 + ta.ch1);
        const v4u au = {a0.x, a0.y, a1.x, a1.y}, bu = {b0.x, b0.y, b1.x, b1.y};
        o0 = MFMA32(__builtin_bit_cast(bf16x8, au), pf, o0);
        o1 = MFMA32(__builtin_bit_cast(bf16x8, bu), pf, o1);
    }
}
#define PACK_P(pw, s0, s1) do { _Pragma("unroll") for (int r_ = 0; r_ < 8; ++r_) { pw[r_] = pk2(s0[2 * r_], s0[2 * r_ + 1]); pw[8 + r_] = pk2(s1[2 * r_], s1[2 * r_ + 1]); } } while (0)
__device__ __forceinline__ int msb64(unsigned long long x) { return 63 - __builtin_clzll(x); }

__device__ __forceinline__ void nsa_unit(const Params& p, LAS unsigned char* lds, int b, int hkv, int i, int tid, int lane, int wave) {
    asm volatile("" : "+v"(tid)); lane = tid & 63;
    unsigned char* ws = p.ws;
    const bf16* Z = (const bf16*)(ws + WS_Z);
    const int col = lane & 31, hi = lane >> 5, g = col >> 3, qp = col & 7;
    const int tq = 8 * wave + qp, t = 64 * i + tq, head = 4 * hkv + g;
    const size_t tok = (size_t)b * S + t;
    const LAS float* lut = (const LAS float*)(lds + LUT_OFF) + head * 128;
    const float bias_far = lut[127];
    LAS float* impw = (LAS float*)(lds + ACC_OFF + wave * 8192);
    LAS float* impw3 = impw + 512;
    LAS float* accs = (LAS float*)(lds + ACC_OFF + wave * 8192) + lane;
    LAS unsigned long long* selor = (LAS unsigned long long*)(lds + MISC4_OFF);
    Ring rg; rg.init(lds, lane, wave);
    const TrAddr tra = tr_addr(lane);
    bf16x8 qf[4];
#pragma unroll
    for (int d0 = 0; d0 < 4; ++d0) qf[d0] = *(const bf16x8*)(Z + tok * ZW + ZQ + head * 64 + d0 * 16 + hi * 8);
    const float* gates = (const float*)(ws + WS_G) + tok * 24 + hkv * 12 + g * 3;
    const float g_c = gates[0], g_s = gates[1], g_w = gates[2];
    const LAS float* pmisc = (const LAS float*)(lds + MISC4_OFF + 2304);
    const bool fastp = pmisc[2] != 0.f;
    float qnorm;
    { float q2 = 0.f;
#pragma unroll
      for (int d0 = 0; d0 < 4; ++d0) { const v4u u = __builtin_bit_cast(v4u, qf[d0]);
          q2 += bflo(u.x) * bflo(u.x) + bfhi(u.x) * bfhi(u.x) + bflo(u.y) * bflo(u.y) + bfhi(u.y) * bfhi(u.y) + bflo(u.z) * bflo(u.z) + bfhi(u.z) * bfhi(u.z) + bflo(u.w) * bflo(u.w) + bfhi(u.w) * bfhi(u.w); }
      q2 += __shfl_xor(q2, 32);
      qnorm = sqrtf(q2) * 1.002f; }
    const bf16* KC = (const bf16*)(ws + WS_KC) + (size_t)(b * 2 + hkv) * 256 * 64;
    const bf16* VCT = (const bf16*)(ws + WS_VCT) + (size_t)(b * 2 + hkv) * 64 * 256;
    const int ntc = (i >> 4) + 1;
    const int cbase = 64 * i + tq - 31 - 64 * hi;
    float m = NEGBIG, l = 0.f;
    RING_DRAIN();
    for (int k = 0; k < 3 && k < ntc; ++k) rg.issue(KC + (size_t)k * 64 * 64, 64, VCT + k * 64, 256, k);
    for (int it = 0; it < ntc; ++it) {
        const int ahead = ntc - 1 - it;
        RING_WAIT(ahead);
        if (it + 3 < ntc) rg.issue(KC + (size_t)(it + 3) * 64 * 64, 64, VCT + (it + 3) * 64, 256, (it + 3) & 3);
        f32x16 s0, s1;
        const bool allfar = (64 * i + 8 * wave - 31 - 1024 * it - 1008) >= 128;
        float mx = NEGBIG;
        if (allfar) {
            qk_tile(lds + (it & 3) * STG_BYTES, qf, col, hi, s0, s1, bias_far);
#pragma unroll
            for (int r = 0; r < 16; ++r) mx = fmaxf(mx, fmaxf(s0[r], s1[r]));
        } else {
            qk_tile(lds + (it & 3) * STG_BYTES, qf, col, hi, s0, s1, 0.f);
            const int db = cbase - 1024 * it;
#pragma unroll
            for (int r = 0; r < 16; ++r) {
                const int d0_ = db - 16 * KKOF(0, r), d1_ = db - 16 * KKOF(1, r);
                const float x0 = s0[r] + lut[min(max(d0_, 0), 127)], x1 = s1[r] + lut[min(max(d1_, 0), 127)];
                s0[r] = d0_ >= 0 ? x0 : NEGBIG; s1[r] = d1_ >= 0 ? x1 : NEGBIG;
                mx = fmaxf(mx, fmaxf(s0[r], s1[r]));
            }
        }
        mx = fmaxf(mx, __shfl_xor(mx, 32));
        const float mn = fmaxf(m, mx);
        float ps = 0.f;
#pragma unroll
        for (int r = 0; r < 16; ++r) { ps += (s0[r] > -1.0e29f ? ex2(s0[r] - mn) : 0.f) + (s1[r] > -1.0e29f ? ex2(s1[r] - mn) : 0.f); }
        l = l * ex2(m - mn) + ps; m = mn;
    }
    WAITV_BAR(0);
    l += __shfl_xor(l, 32);
    const float inv_lc = l > 0.f ? rcp(l) : 0.f;
    f32x16 oc0, oc1;
#pragma unroll
    for (int r = 0; r < 16; ++r) { oc0[r] = 0.f; oc1[r] = 0.f; }
    for (int it = 0; it < ntc; ++it) {
        f32x16 s0, s1;
        const bool allfar = (64 * i + 8 * wave - 31 - 1024 * it - 1008) >= 128;
        if (allfar) {
            qk_tile(lds + (it & 3) * STG_BYTES, qf, col, hi, s0, s1, bias_far - m);
#pragma unroll
            for (int r = 0; r < 16; ++r) { s0[r] = ex2(s0[r]) * inv_lc; s1[r] = ex2(s1[r]) * inv_lc; }
        } else {
            qk_tile(lds + (it & 3) * STG_BYTES, qf, col, hi, s0, s1, 0.f);
            const int db = cbase - 1024 * it;
#pragma unroll
            for (int r = 0; r < 16; ++r) {
                const int d0_ = db - 16 * KKOF(0, r), d1_ = db - 16 * KKOF(1, r);
                const float x0 = s0[r] + lut[min(max(d0_, 0), 127)], x1 = s1[r] + lut[min(max(d1_, 0), 127)];
                s0[r] = d0_ >= 0 ? ex2(x0 - m) * inv_lc : 0.f; s1[r] = d1_ >= 0 ? ex2(x1 - m) * inv_lc : 0.f;
            }
        }
#pragma unroll
        for (int k4 = 0; k4 < 4; ++k4) {
            float pa0 = (s0[4 * k4] + s0[4 * k4 + 1]) + (s0[4 * k4 + 2] + 0.5f * s0[4 * k4 + 3]), pc0 = 0.5f * s0[4 * k4 + 3];
            float pa1 = (s1[4 * k4] + s1[4 * k4 + 1]) + (s1[4 * k4 + 2] + 0.5f * s1[4 * k4 + 3]), pc1 = 0.5f * s1[4 * k4 + 3];
            pa0 += __shfl_xor(pa0, 8); pa0 += __shfl_xor(pa0, 16); pc0 += __shfl_xor(pc0, 8); pc0 += __shfl_xor(pc0, 16);
            pa1 += __shfl_xor(pa1, 8); pa1 += __shfl_xor(pa1, 16); pc1 += __shfl_xor(pc1, 8); pc1 += __shfl_xor(pc1, 16);
            if (g == 0) { const int n0 = 16 * it + 2 * k4 + hi;
                impw[qp * 64 + n0] = pa0; impw3[qp * 64 + n0] = pc0; impw[qp * 64 + n0 + 8] = pa1; impw3[qp * 64 + n0 + 8] = pc1; }
        }
        unsigned pw[16]; PACK_P(pw, s0, s1);
        pv_tile(lds + (it & 3) * STG_BYTES + 8192, pw, col, hi, oc0, oc1);
    }
    LDS_WAIT();
    unsigned long long mysel = 0ull, wsel = 0ull;
    {
        const unsigned long long curmask = (i == 63) ? ~0ull : ((1ull << (i + 1)) - 1ull);
        const int want = i + 1 < 16 ? i + 1 : 16;
        const int n = lane;
        LAS float* vbuf = (LAS float*)(lds + MISC4_OFF + 256 + wave * 256);
        for (int q = 0; q < 8; ++q) {
            float v = impw[q * 64 + n] + (n > 0 ? impw3[q * 64 + n - 1] : 0.f) + ((n == 0 || n == i || n == i - 1) ? 1.0e4f : 0.f);
            v = (n <= i) ? v : -1.0e9f;
            vbuf[n] = v;
            LDS_WAIT();
            int cgt = 0;
#pragma unroll
            for (int m4 = 0; m4 < 16; ++m4) { const f32x4 w = *(const LAS f32x4*)(vbuf + 4 * m4); cgt += (w.x > v ? 1 : 0) + (w.y > v ? 1 : 0) + (w.z > v ? 1 : 0) + (w.w > v ? 1 : 0); }
            LDS_WAIT();
            unsigned long long sel = __ballot(cgt < 16) & curmask;
            if (__builtin_popcountll(sel) != want) {
                int rank = 0;
#pragma unroll 8
                for (int mm = 0; mm < 64; ++mm) { const float vm = vbuf[mm]; rank += (vm > v || (vm == v && mm < n)) ? 1 : 0; }
                LDS_WAIT();
                sel = __ballot(rank < 16) & curmask;
            }
            if (qp == q) mysel = sel;
            wsel |= sel;
        }
    }
    LDS_WAIT();
#pragma unroll
    for (int r = 0; r < 16; ++r) { accs[r * 64] = oc0[r] * g_c; accs[(16 + r) * 64] = oc1[r] * g_c; }
    if (lane == 0) selor[wave] = wsel;
    __syncthreads();
    unsigned long long U = 0ull;
#pragma unroll
    for (int w = 0; w < 8; ++w) U |= selor[w];
    U = ((unsigned long long)__builtin_amdgcn_readfirstlane((unsigned)(U >> 32)) << 32) | (unsigned long long)__builtin_amdgcn_readfirstlane((unsigned)U);
    const v4u onesu = {0x3f803f80u, 0x3f803f80u, 0x3f803f80u, 0x3f803f80u};
    const bf16x8 ones = __builtin_bit_cast(bf16x8, onesu);
    constexpr float THR = 8.0f;
#pragma unroll 1
    for (int mode = 0; mode < 2; ++mode) {
        const bf16* Kb = Z + (size_t)b * S * ZW + (mode ? ZKW : ZKS) + hkv * 64;
        const bf16* Vb = Z + (size_t)b * S * ZW + (mode ? ZVW : ZVS) + hkv * 64;
        unsigned long long Tm;
        if (mode == 0) Tm = U;
        else { const int jlo = i >= 8 ? i - 8 : 0; const unsigned long long hm = (i == 63) ? ~0ull : ((1ull << (i + 1)) - 1ull); Tm = hm & ~((1ull << jlo) - 1ull); }
        const unsigned long long wm = mode ? Tm : wsel;
        const unsigned long long lm = mode ? Tm : mysel;
        const int dmax = mode ? 512 : 0x40000000;
        f32x16 o0, o1, os, cfar;
#pragma unroll
        for (int r = 0; r < 16; ++r) { o0[r] = 0.f; o1[r] = 0.f; os[r] = 0.f; }
        float mref = fastp ? qnorm * pmisc[mode] + pmisc[8 + head] : 0.f;
#pragma unroll
        for (int r = 0; r < 16; ++r) cfar[r] = bias_far - mref;
        const int nt = __builtin_popcountll(Tm);
        unsigned long long irem = Tm, crem = Tm;
        for (int k = 0; k < 3 && k < nt; ++k) { const int ji = msb64(irem); irem &= ~(1ull << ji); rg.issue(Kb + (size_t)ji * 64 * ZW, ZW, Vb + (size_t)ji * 64 * ZW, ZW, k); }
        if (fastp) {
        for (int it = 0; it < nt; ++it) {
            const int j = msb64(crem); crem &= ~(1ull << j);
            const int ahead = nt - 1 - it;
            RING_WAIT(ahead);
            if (it + 3 < nt) { const int ji = msb64(irem); irem &= ~(1ull << ji); rg.issue(Kb + (size_t)ji * 64 * ZW, ZW, Vb + (size_t)ji * 64 * ZW, ZW, (it + 3) & 3); }
                if ((wm >> j) & 1ull) {
                    const LAS unsigned char* stg = lds + (it & 3) * STG_BYTES;
                    const int dj = i - j;
                    const bool lsel = (lm >> j) & 1ull;
                    const int db = 64 * dj + tq - 4 * hi;
#pragma unroll
                    for (int hf = 0; hf < 2; ++hf) {
                        f32x16 s; unsigned pw[8];
                        if (dj <= 2) {
                            qk_half(stg, qf, col, hi, hf, s, -mref);
                            const LAS float* l2p = (const LAS float*)(lds + LUT2_OFF) + head * 260 + db + 5;
#pragma unroll
                            for (int r = 0; r < 16; ++r) { const float x = s[r] + l2p[63 - KKOF(hf, r)]; s[r] = (lsel && KKOF(hf, r) <= db) ? ex2(x) : 0.f; }
#pragma unroll
                            for (int r = 0; r < 8; ++r) pw[r] = pk2(s[2 * r], s[2 * r + 1]);
                        } else if (dj == 8) {
                            qk_half_c(stg, qf, col, hi, hf, s, cfar);
#pragma unroll
                            for (int r = 0; r < 16; ++r) { const int d_ = db - KKOF(hf, r); s[r] = (lsel && d_ < dmax) ? ex2(s[r]) : 0.f; }
#pragma unroll
                            for (int r = 0; r < 8; ++r) pw[r] = pk2(s[2 * r], s[2 * r + 1]);
                        } else {
                            qk_half_c(stg, qf, col, hi, hf, s, cfar);
#pragma unroll
                            for (int r = 0; r < 8; ++r) { const unsigned w_ = pk2(ex2(s[2 * r]), ex2(s[2 * r + 1])); pw[r] = lsel ? w_ : 0u; }
                        }
                        pv_half_tr(stg + 8192, pw, tra, hf, o0, o1, os, ones);
                    }
                }
        }
        } else {
        for (int it = 0; it < nt; ++it) {
            const int j = msb64(crem); crem &= ~(1ull << j);
            const int ahead = nt - 1 - it;
            RING_WAIT(ahead);
            if (it + 3 < nt) { const int ji = msb64(irem); irem &= ~(1ull << ji); rg.issue(Kb + (size_t)ji * 64 * ZW, ZW, Vb + (size_t)ji * 64 * ZW, ZW, (it + 3) & 3); }
            if ((wm >> j) & 1ull) {
                const LAS unsigned char* stg = lds + (it & 3) * STG_BYTES;
                const int dj = i - j;
                const bool nearb = dj <= 2;
                const bool lsel = (lm >> j) & 1ull;
                const int db = 64 * dj + tq - 4 * hi;
#pragma unroll
                for (int hf = 0; hf < 2; ++hf) {
                    f32x16 s;
                    float mx = NEGBIG;
                    if (nearb) {
                        qk_half(stg, qf, col, hi, hf, s, -mref);
#pragma unroll
                        for (int r = 0; r < 16; ++r) { const int d_ = db - KKOF(hf, r); const float x = s[r] + lut[min(max(d_, 0), 127)]; s[r] = (lsel && d_ >= 0) ? x : NEGBIG; mx = fmaxf(mx, s[r]); }
                    } else if (dj == 8) {
                        qk_half(stg, qf, col, hi, hf, s, bias_far - mref);
#pragma unroll
                        for (int r = 0; r < 16; ++r) { const int d_ = db - KKOF(hf, r); s[r] = (lsel && d_ < dmax) ? s[r] : NEGBIG; mx = fmaxf(mx, s[r]); }
                    } else {
                        qk_half(stg, qf, col, hi, hf, s, lsel ? bias_far - mref : NEGBIG);
#pragma unroll
                        for (int r = 0; r < 16; ++r) mx = fmaxf(mx, s[r]);
                    }
                    { auto rr_ = __builtin_amdgcn_permlane32_swap(__float_as_uint(mx), __float_as_uint(mx), false, false); mx = fmaxf(__uint_as_float(rr_[0]), __uint_as_float(rr_[1])); }
                    if (dj == 0 && hf == 0) {
                        mref = mx;
#pragma unroll
                        for (int r = 0; r < 16; ++r) s[r] -= mx;
                    } else if (__any(mx > THR)) {
                        const float dl = mx > THR ? mx : 0.f; mref += dl; const float scl = ex2(-dl);
#pragma unroll
                        for (int r = 0; r < 16; ++r) s[r] -= dl;
                        o0 = o0 * scl; o1 = o1 * scl; os = os * scl;
                    }
                    unsigned pw[8];
#pragma unroll
                    for (int r = 0; r < 8; ++r) pw[r] = pk2(ex2(s[2 * r]), ex2(s[2 * r + 1]));
                    pv_half_tr(stg + 8192, pw, tra, hf, o0, o1, os, ones);
                }
            }
        }
        }
        WAITV_BAR(0);
        l = os[0];
        const float f = (mode ? g_w : g_s) * (l > 0.f ? rcp(l) : 0.f);
        if (mode == 0) {
#pragma unroll
            for (int r = 0; r < 16; ++r) { accs[r * 64] += o0[r] * f; accs[(16 + r) * 64] += o1[r] * f; }
        } else {
            bf16* O = (bf16*)(ws + WS_ATTA) + tok * 1024 + head * 64 + 4 * hi;
#pragma unroll
            for (int r = 0; r < 16; ++r) { o0[r] = accs[r * 64] + o0[r] * f; o1[r] = accs[(16 + r) * 64] + o1[r] * f; }
#pragma unroll
            for (int k4 = 0; k4 < 4; ++k4) {
                v2u w0; w0.x = pk2(o0[4 * k4], o0[4 * k4 + 1]); w0.y = pk2(o0[4 * k4 + 2], o0[4 * k4 + 3]);
                v2u w1; w1.x = pk2(o1[4 * k4], o1[4 * k4 + 1]); w1.y = pk2(o1[4 * k4 + 2], o1[4 * k4 + 3]);
                *(v2u*)(O + 8 * k4) = w0; *(v2u*)(O + 32 + 8 * k4) = w1;
            }
        }
    }
}

template <bool MK> __device__ __forceinline__ void sb_scan(f32x16& s0, f32x16& s1, int db, int hi, float& R) {
            f32x16 k0, k1;
#pragma unroll
            for (int r = 0; r < 16; ++r) {
                const float e0 = ex2(fminf(s0[r], 80.f)), e1 = ex2(fminf(s1[r], 80.f));
                const float p0 = rcp(1.0f + e0), p1 = rcp(1.0f + e1);
                s0[r] = e0 * p0; s1[r] = e1 * p1;
                k0[r] = (!MK || KKOF(0, r) < db) ? p0 : 1.0f; k1[r] = (!MK || KKOF(1, r) < db) ? p1 : 1.0f;
            }
            float g4[8], pg[8], E[8];
#pragma unroll
            for (int k4 = 0; k4 < 4; ++k4) { g4[k4] = (k0[4 * k4] * k0[4 * k4 + 1]) * (k0[4 * k4 + 2] * k0[4 * k4 + 3]); g4[4 + k4] = (k1[4 * k4] * k1[4 * k4 + 1]) * (k1[4 * k4 + 2] * k1[4 * k4 + 3]); }
#pragma unroll
            for (int G = 0; G < 8; ++G) pg[G] = __shfl_xor(g4[G], 32);
            E[7] = 1.0f;
#pragma unroll
            for (int G = 6; G >= 0; --G) E[G] = E[G + 1] * (g4[G + 1] * pg[G + 1]);
            const float T = E[0] * (g4[0] * pg[0]);
#pragma unroll
            for (int G = 0; G < 8; ++G) {
                const float base = R * E[G] * (hi == 0 ? pg[G] : 1.0f);
                const int k4 = G & 3;
                if (G < 4) {
                    const float u3 = base, u2 = u3 * k0[4 * k4 + 3], u1 = u2 * k0[4 * k4 + 2], u0 = u1 * k0[4 * k4 + 1];
                    s0[4 * k4 + 3] = (!MK || KKOF(0, 4 * k4 + 3) < db) ? s0[4 * k4 + 3] * u3 : 0.f;
                    s0[4 * k4 + 2] = (!MK || KKOF(0, 4 * k4 + 2) < db) ? s0[4 * k4 + 2] * u2 : 0.f;
                    s0[4 * k4 + 1] = (!MK || KKOF(0, 4 * k4 + 1) < db) ? s0[4 * k4 + 1] * u1 : 0.f;
                    s0[4 * k4 + 0] = (!MK || KKOF(0, 4 * k4 + 0) < db) ? s0[4 * k4 + 0] * u0 : 0.f;
                } else {
                    const float u3 = base, u2 = u3 * k1[4 * k4 + 3], u1 = u2 * k1[4 * k4 + 2], u0 = u1 * k1[4 * k4 + 1];
                    s1[4 * k4 + 3] = (!MK || KKOF(1, 4 * k4 + 3) < db) ? s1[4 * k4 + 3] * u3 : 0.f;
                    s1[4 * k4 + 2] = (!MK || KKOF(1, 4 * k4 + 2) < db) ? s1[4 * k4 + 2] * u2 : 0.f;
                    s1[4 * k4 + 1] = (!MK || KKOF(1, 4 * k4 + 1) < db) ? s1[4 * k4 + 1] * u1 : 0.f;
                    s1[4 * k4 + 0] = (!MK || KKOF(1, 4 * k4 + 0) < db) ? s1[4 * k4 + 0] * u0 : 0.f;
                }
            }
            R *= T;
}

__device__ __forceinline__ void sb_unit(const Params& p, LAS unsigned char* lds, int b, int hp, int qb, int tid, int lane, int wave) {
    asm volatile("" : "+v"(tid)); lane = tid & 63;
    unsigned char* ws = p.ws;
    const bf16* Z = (const bf16*)(ws + WS_Z);
    const int col = lane & 31, hi = lane >> 5, w4 = wave & 3, hsel = wave >> 2, h = 2 * hp + hsel;
    const int t = 128 * qb + 32 * w4 + col;
    const size_t tok = (size_t)b * S + t;
    const int tmaxw = 128 * qb + 32 * w4 + 31;
    LAS int* flags = (LAS int*)(lds + MISC4_OFF + 128);
    Ring rg; rg.init(lds, lane, wave);
    bf16x8 qf[4];
#pragma unroll
    for (int d0 = 0; d0 < 4; ++d0) { const v4u raw = *(const v4u*)(Z + tok * ZW + ZQB + h * 64 + d0 * 16 + hi * 8);
        constexpr float QS = 0.125f * LOG2E;
        v4u sc; sc.x = pk2(bflo(raw.x) * QS, bfhi(raw.x) * QS); sc.y = pk2(bflo(raw.y) * QS, bfhi(raw.y) * QS);
        sc.z = pk2(bflo(raw.z) * QS, bfhi(raw.z) * QS); sc.w = pk2(bflo(raw.w) * QS, bfhi(raw.w) * QS);
        qf[d0] = __builtin_bit_cast(bf16x8, sc); }
    const bf16* Kb = Z + (size_t)b * S * ZW + ZKB + 2 * hp * 64;
    const bf16* Vb = Z + (size_t)b * S * ZW + ZVB + 2 * hp * 64;
    const TrAddr tra = tr_addr(lane);
    f32x16 o0, o1;
#pragma unroll
    for (int r = 0; r < 16; ++r) { o0[r] = 0.f; o1[r] = 0.f; }
    float R = 1.0f; bool dead = false;
    const int jtop = 2 * qb + 1, nt = jtop + 1;
    if (tid < 16) flags[tid] = 0;
    RING_DRAIN();
    for (int k = 0; k < 3 && k < nt; ++k) rg.issue4(Kb + (size_t)(jtop - k) * 64 * ZW, Vb + (size_t)(jtop - k) * 64 * ZW, ZW, k);
    for (int it = 0; it < nt; ++it) {
        const int j = jtop - it;
        const int ahead = nt - 1 - it;
        RING_WAIT4(ahead);
        if (it > 0) { int alld = 1;
#pragma unroll
            for (int w = 0; w < 8; ++w) alld &= flags[((it - 1) & 1) * 8 + w];
            if (alld) break; }
        if (it + 3 < nt) rg.issue4(Kb + (size_t)(j - 3) * 64 * ZW, Vb + (size_t)(j - 3) * 64 * ZW, ZW, (it + 3) & 3);
        if (!dead && 64 * j < tmaxw) {
            const LAS unsigned char* stg = lds + (it & 3) * (2 * STG_BYTES) + hsel * STG_BYTES;
            f32x16 s0, s1;
            qk_tile(stg, qf, col, hi, s0, s1, 0.f);
            const int db = t - 64 * j - 4 * hi;
            if (64 * j + 63 < tmaxw - 31) sb_scan<false>(s0, s1, db, hi, R); else sb_scan<true>(s0, s1, db, hi, R);
            unsigned pw[16]; PACK_P(pw, s0, s1);
            pv_tile_tr(stg + 8192, pw, tra, o0, o1);
            dead = __all(R < 1.0e-44f);
        }
        if (lane == 0) flags[(it & 1) * 8 + wave] = dead ? 1 : 0;
    }
    WAITV_BAR(0);
    bf16* O = (bf16*)(ws + WS_ATTA) + tok * 1024 + 512 + h * 64 + 4 * hi;
#pragma unroll
    for (int k4 = 0; k4 < 4; ++k4) {
        v2u w0; w0.x = pk2(o0[4 * k4], o0[4 * k4 + 1]); w0.y = pk2(o0[4 * k4 + 2], o0[4 * k4 + 3]);
        v2u w1; w1.x = pk2(o1[4 * k4], o1[4 * k4 + 1]); w1.y = pk2(o1[4 * k4 + 2], o1[4 * k4 + 3]);
        *(v2u*)(O + 8 * k4) = w0; *(v2u*)(O + 32 + 8 * k4) = w1;
    }
}

__device__ __forceinline__ void phase4(const Params& p, LAS unsigned char* lds, int tid, int lane, int wave) {
    for (int vb = blockIdx.x; vb < 256; vb += gridDim.x) {
    const int v = (vb & 7) * 32 + (vb >> 3);
    __syncthreads();
    { const float* rel = p.in[2]; LAS float* lut = (LAS float*)(lds + LUT_OFF);
      for (int e = tid; e < 1024; e += 512) { const int head = e >> 7, dist = e & 127;
          int bk = dist; if (dist >= 16) { bk = 16 + (int)(logf((float)dist / 16.0f) / 2.0794415416798357f * 16.0f); bk = bk < 31 ? bk : 31; }
          lut[e] = rel[bk * 8 + head] * LOG2E; } }
    __syncthreads();
    { const LAS float* lut = (const LAS float*)(lds + LUT_OFF); LAS float* l2 = (LAS float*)(lds + LUT2_OFF);
      for (int e = tid; e < 8 * 260; e += 512) { const int head = e / 260, d = e % 260 - 68; l2[e] = d < 0 ? 0.f : lut[head * 128 + (d < 127 ? d : 127)]; } }
    if (wave == 0) { const float* qg = p.in[13]; const float* kg = p.in[14]; LAS float* pm = (LAS float*)(lds + MISC4_OFF + 2304); const LAS float* lut = (const LAS float*)(lds + LUT_OFF);
        float a = fabsf(qg[lane]), b1 = fabsf(kg[64 + lane]), b2 = fabsf(kg[128 + lane]);
#pragma unroll
        for (int o = 1; o < 64; o <<= 1) { a = fmaxf(a, __shfl_xor(a, o)); b1 = fmaxf(b1, __shfl_xor(b1, o)); b2 = fmaxf(b2, __shfl_xor(b2, o)); }
        float bm = -1.0e30f, ball = 0.f;
        if (lane < 8) {
            for (int d = 0; d < 128; ++d) bm = fmaxf(bm, lut[lane * 128 + d]);
            pm[8 + lane] = bm; }
        ball = lane < 8 ? bm : -1.0e30f;
#pragma unroll
        for (int o = 1; o < 64; o <<= 1) ball = fmaxf(ball, __shfl_xor(ball, o));
        const float kn1 = 8.0f * b1 * 1.004f, kn2 = 8.0f * b2 * 1.004f, qmax = 8.0f * a * 0.125f * LOG2E * 1.004f;
        const float worst = qmax * fmaxf(kn1, kn2) + fmaxf(ball, 0.f);
        if (lane == 0) { pm[0] = kn1; pm[1] = kn2; pm[2] = (worst < 48.0f) ? 1.0f : 0.0f; } }
    __syncthreads();
        { const int pair = v >> 3, s = v & 7, b = pair >> 1, hkv = pair & 1;
#pragma unroll 1
          for (int u = 0; u < 8; ++u) { const int i = (u & 1) ? (16 * (u >> 1) + 15 - s) : (16 * (u >> 1) + s);
 for (int rep_ = 0; rep_ < REP_NSA; ++rep_) nsa_unit(p, lds, b, hkv, i, tid, lane, wave);
 } }
        { const int pair = v >> 2, b = pair >> 2, hp = pair & 3;
#pragma unroll 1
          for (int u = 0; u < 8; ++u) { const int qb = (v & 3) + 4 * u;
 for (int rep_ = 0; rep_ < REP_SB; ++rep_) sb_unit(p, lds, b, hp, qb, tid, lane, wave);
 } }
    }
}

#define XB_TMO      128
#define XB_XCNT(j)  (256  + 64 * (j))
#define XB_XSUB(j)  (1280 + 64 * (j))
#define XB_XGEN(j)  (2304 + 64 * (j))
#define XB_TOP      3328
#define XB_TOPGEN   3392
#define XCD_BAR_WORDS 3456
#define XB_SPIN_CAP (1u << 18)

__device__ __forceinline__ unsigned xb_ld(unsigned* p)              { return __hip_atomic_load(p, __ATOMIC_RELAXED, __HIP_MEMORY_SCOPE_AGENT); }
__device__ __forceinline__ unsigned xb_add(unsigned* p, unsigned v) { return __hip_atomic_fetch_add(p, v, __ATOMIC_RELAXED, __HIP_MEMORY_SCOPE_AGENT); }
__device__ __forceinline__ unsigned xb_xcc_id() { return (unsigned)__builtin_amdgcn_s_getreg((3 << 11) | 20) & 0xFu; }
#define XB_SPIN(cond, bar) do { unsigned _sp = 0; while (cond) { __builtin_amdgcn_s_sleep(1); \
    if ((++_sp & 255u) == 0u) { if (xb_ld(&(bar)[XB_TMO])) break; if (_sp > XB_SPIN_CAP) { atomicAdd(&(bar)[XB_TMO], 1u); break; } } } } while (0)

struct XcdBarrier {
    unsigned* bar; unsigned x;
    volatile LAS unsigned* st;
};

__device__ __forceinline__ XcdBarrier xcd_barrier_post(unsigned* bar, volatile LAS unsigned* st) {
    XcdBarrier b; b.bar = bar; b.x = xb_xcc_id(); b.st = st;
    if (threadIdx.x == 0) (void)xb_add(&bar[XB_XCNT(b.x)], 1u);
    return b;
}
__device__ __forceinline__ void xcd_barrier_complete(unsigned* bar, unsigned x, unsigned& nloc, unsigned& nx) {
    const unsigned G = gridDim.x * gridDim.y * gridDim.z;
    unsigned sum, cnt, mine, sp = 0u;
    for (;;) {
        sum = 0u; cnt = 0u; mine = 0u;
#pragma unroll
        for (unsigned j = 0; j < 16; ++j) { const unsigned c = xb_ld(&bar[XB_XCNT(j)]); sum += c; cnt += (c > 0u) ? 1u : 0u; mine = (j == x) ? c : mine; }
        if (sum == G) break;
        __builtin_amdgcn_s_sleep(1);
        if ((++sp & 255u) == 0u) { if (xb_ld(&bar[XB_TMO])) break; if (sp > XB_SPIN_CAP) { atomicAdd(&bar[XB_TMO], 1u); break; } }
    }
    nloc = mine > 0u ? mine : 1u; nx = cnt > 0u ? cnt : 1u;
}

__device__ __forceinline__ void xcd_barrier(const XcdBarrier& b) {
    asm volatile("s_waitcnt vmcnt(0)" ::: "memory");
    __syncthreads();
    if (threadIdx.x == 0) {
        unsigned* bar = b.bar;
        __builtin_amdgcn_s_waitcnt(0);
        unsigned nloc = b.st[0], nx = b.st[1];
        if (nloc == 0u) { xcd_barrier_complete(bar, b.x, nloc, nx); b.st[0] = nloc; b.st[1] = nx; }
        const unsigned old = xb_add(&bar[XB_XSUB(b.x)], 1u);
        const unsigned gen = old / nloc;
        if (old + 1u == (gen + 1u) * nloc) {
            __builtin_amdgcn_fence(__ATOMIC_RELEASE, "agent");
            asm volatile("s_waitcnt vmcnt(0)" ::: "memory");
            const unsigned og = xb_add(&bar[XB_TOP], 1u);
            const unsigned tg = og / nx;
            if (og + 1u == (tg + 1u) * nx) xb_add(&bar[XB_TOPGEN], 1u);
            else XB_SPIN(xb_ld(&bar[XB_TOPGEN]) == tg, bar);
            __builtin_amdgcn_fence(__ATOMIC_ACQUIRE, "agent");
            xb_add(&bar[XB_XGEN(b.x)], 1u);
            asm volatile("s_waitcnt vmcnt(0)" ::: "memory");
        } else {
            XB_SPIN(xb_ld(&bar[XB_XGEN(b.x)]) == gen, bar);
            __builtin_amdgcn_fence(__ATOMIC_ACQUIRE, "agent");
            asm volatile("s_waitcnt vmcnt(0)" ::: "memory");
        }
    }
    __syncthreads();
}

constexpr int XB_LDS_OFF = LDS_BYTES - 16;
constexpr size_t WS_BAR = 65536;

__global__ void __launch_bounds__(NWAVES * 64, 2) fwd_megakernel(Params p) {
    extern __shared__ __attribute__((aligned(16))) unsigned char lds_raw[];
    LAS unsigned char* lds = (LAS unsigned char*)lds_raw;
    cg::grid_group grid = cg::this_grid();
    if (threadIdx.x < 4) ((volatile LAS unsigned*)(lds + XB_LDS_OFF))[threadIdx.x] = 0u;
    __syncthreads();
    const XcdBarrier xbar = xcd_barrier_post((unsigned*)(p.ws + WS_BAR), (volatile LAS unsigned*)(lds + XB_LDS_OFF));
    int tid = threadIdx.x, lane = tid & 63, wave = __builtin_amdgcn_readfirstlane(tid >> 6);
#define RELAUNDER() do { tid = threadIdx.x; asm volatile("" : "+v"(tid)); lane = tid & 63; wave = __builtin_amdgcn_readfirstlane(tid >> 6); } while (0)
    unsigned char* ws = p.ws;
    bf16* XN = (bf16*)(ws + WS_XN); bf16* Zb = (bf16*)(ws + WS_Z); float* mod = (float*)(ws + WS_MOD);
    const int G = gridDim.x;

    RELAUNDER();
    for (int rep_ = 0; rep_ < REP_P0; ++rep_) { phase0(p, lds, tid, lane, wave); __syncthreads(); }
    grid.sync();
    RELAUNDER();
    for (int rep_ = 0; rep_ < REP_P1; ++rep_) norm_rows(p.in[0], p.in[5], mod, 0, 1024, XN, lane, wave);
    xcd_barrier(xbar);
    { pg8::Gemm g{XN, (const bf16*)(ws + WS_WIN), M, NIN, DM}; pg8::StaticOrder So; So.init(M, NIN, G, (int)blockIdx.x);
      pg8::EpiZ E{Zb, (float*)(ws + WS_G)};
      pg8::gemm_phase<pg8::EpiZ, pg8::StaticOrder, true, true>(lds, g, So, E); }
    xcd_barrier(xbar);
    RELAUNDER();
    for (int rep_ = 0; rep_ < REP_P3; ++rep_) { phase3(p, lds, tid, lane, wave, rep_ == 0); __syncthreads(); }
    xcd_barrier(xbar);
    RELAUNDER();
#ifndef SKIP_P4
    phase4(p, lds, tid, lane, wave);
#endif
    xcd_barrier(xbar);
    { pg8::Gemm g{(const bf16*)(ws + WS_ATTA), (const bf16*)(ws + WS_WUPA), M, DM, DM}; pg8::StaticOrder So; So.init(M, DM, G, (int)blockIdx.x);
      pg8::EpiUpF E{XN, Zb};
      pg8::gemm_phase<pg8::EpiUpF, pg8::StaticOrder, true, true>(lds, g, So, E); }
    xcd_barrier(xbar);
    { pg8::Gemm g{XN, (const bf16*)(ws + WS_WOUT), M, DM, DM}; pg8::StaticOrder So; So.init(M, DM, G, (int)blockIdx.x);
      pg8::EpiRes2 E{p.in[0], p.out, mod + 2048, p.in[6], mod + 4096, (bf16*)(ws + WS_ATTA), (float*)(ws + WS_ROWSS)};
      pg8::gemm_phase<pg8::EpiRes2, pg8::StaticOrder, true, true>(lds, g, So, E); }
    xcd_barrier(xbar);
    { pg8::Gemm g{(const bf16*)(ws + WS_ATTA), (const bf16*)(ws + WS_W1), M, FF, DM}; pg8::StaticOrder So; So.init(M, FF, G, (int)blockIdx.x);
      pg8::EpiRelu2N E{Zb, (const float*)(ws + WS_ROWSS), (const float*)(ws + WS_SW)};
      pg8::gemm_phase<pg8::EpiRelu2N, pg8::StaticOrder, true, true>(lds, g, So, E); }
    xcd_barrier(xbar);
    { pg8::Gemm g{Zb, (const bf16*)(ws + WS_W2), M, DM, FF}; pg8::StaticOrder So; So.init(M, DM, G, (int)blockIdx.x);
      pg8::EpiRes E{p.out, p.out, mod + 5120};
      pg8::gemm_phase<pg8::EpiRes, pg8::StaticOrder, true, true>(lds, g, So, E); }
}

extern "C" void kernel_launch(void* const* d_in, const int* in_sizes, int n_in, void* d_out, int out_size, void* d_ws, size_t ws_size, hipStream_t stream) {
    static int grid = 0;
    if (grid == 0) {
        if (n_in != 20 || ws_size < WS_END) { fprintf(stderr, "kernel_launch: unexpected inputs (n_in %d, ws %zu)\n", n_in, ws_size); grid = -1; return; }
        int dev = 0, cus = 0, per_cu = 0;
        hipGetDevice(&dev); hipDeviceGetAttribute(&cus, hipDeviceAttributeMultiprocessorCount, dev);
        if (hipFuncSetAttribute((const void*)fwd_megakernel, hipFuncAttributeMaxDynamicSharedMemorySize, LDS_BYTES) != hipSuccess) fprintf(stderr, "kernel_launch: hipFuncSetAttribute failed\n");
        if (hipOccupancyMaxActiveBlocksPerMultiprocessor(&per_cu, (const void*)fwd_megakernel, NWAVES * 64, LDS_BYTES) != hipSuccess || per_cu < 1) { fprintf(stderr, "kernel_launch: occupancy query gave %d\n", per_cu); per_cu = 1; }
        (void)hipGetLastError();
        grid = cus * per_cu;
    }
    if (grid < 0) return;
    if (hipMemsetAsync(d_ws, 0, 1 << 20, stream) != hipSuccess) { fprintf(stderr, "kernel_launch: hipMemsetAsync of the barrier words failed\n"); return; }
    Params p{};
    for (int i = 0; i < 20; ++i) p.in[i] = (const float*)d_in[i];
    p.out = (float*)d_out; p.ws = (unsigned char*)d_ws;
    void* args[] = {&p};
    hipError_t e = hipLaunchCooperativeKernel((const void*)fwd_megakernel, dim3(grid), dim3(NWAVES * 64), args, LDS_BYTES, stream);
    if (e != hipSuccess) fprintf(stderr, "kernel_launch: cooperative launch failed: %s (grid %d)\n", hipGetErrorString(e), grid);
}
```

```cpp
#include <hip/hip_runtime.h>
#include <hip/hip_cooperative_groups.h>
#include <cstdio>
#include <cstdint>
namespace cg = cooperative_groups;

constexpr int NB = 16, S = 4096, DM = 1024, M = NB * S, FF = 4096;
constexpr int ZW = 4864;
constexpr int ZQ = 0, ZKC = 512, ZVC = 640, ZKS = 768, ZVS = 896, ZKW = 1024, ZVW = 1152, ZQB = 1280, ZKB = 1792, ZVB = 2304, ZMA = 2816, ZMB = 3840;
constexpr int NIN = 5120;
constexpr size_t MiB = (size_t)1 << 20;
constexpr size_t WS_WIN = 1 * MiB, WS_WUPA = 11 * MiB, WS_WUPB = 12 * MiB, WS_WOUT = 13 * MiB, WS_W1 = 15 * MiB, WS_W2 = 23 * MiB;
constexpr size_t WS_MOD = 31 * MiB, WS_PW1 = 31 * MiB + 400 * 1024, WS_CW1K = 31 * MiB + 512 * 1024, WS_CW1V = WS_CW1K + 256 * 1024;
constexpr size_t WS_KC = 32 * MiB, WS_VCT = 33 * MiB, WS_VST = 34 * MiB, WS_VWT = 50 * MiB, WS_VBT = 66 * MiB;
constexpr size_t WS_XN = 130 * MiB, WS_ATTA = 258 * MiB, WS_ATTB = 322 * MiB, WS_Z = 386 * MiB, WS_G = 994 * MiB, WS_ROWSS = 1000 * MiB, WS_SW = 1001 * MiB, WS_END = 1002 * MiB;
constexpr float LOG2E = 1.4426950408889634f, LN2 = 0.6931471805599453f;
#ifndef REP_NSA
#define REP_NSA 1
#endif
#ifndef REP_SB
#define REP_SB 1
#endif
#define REP_P0 1
#define REP_P1 1
#define REP_P3 1
namespace pg8 {
#define PG8_LAS __attribute__((address_space(3)))
typedef unsigned short bf16_t;
typedef short bf16x8 __attribute__((ext_vector_type(8)));
typedef float f32x4 __attribute__((ext_vector_type(4)));
typedef unsigned u32x4 __attribute__((ext_vector_type(4)));
constexpr int BM = 256, BK = 64, HALF = 128, HTB = HALF * BK * 2  , STAGE_BYTES = 8 * HTB, NXCD = 8, WGM = 8;

__host__ __device__ __forceinline__ int lds_byte(int r, int c) { const int st = (r >> 4) * 2 + (c >> 5), rr = r & 15, cc = c & 31, ob = rr * 64 + cc * 2; return st * 1024 + (ob ^ (((ob >> 9) & 1) << 5)); }
__host__ __device__ __forceinline__ void stage_rc(int b, int& R, int& C) { const int st = b / 1024, sb = b % 1024, swz = sb ^ (((sb >> 9) & 1) << 5); R = (st >> 1) * 16 + swz / 64; C = (st & 1) * 32 + (swz % 64) / 2; }
__host__ __device__ __forceinline__ int perm32(int rho) { const int n = rho >> 4, i = rho & 15; return 8 * (i >> 2) + 4 * n + (i & 3); }

struct Unit { int pm, pn; };
struct Gemm { const bf16_t* A; const bf16_t* Bt; int M, N, K; };

struct StaticOrder {
    int nM, nN, nwg, G, c;
    __host__ __device__ void init(int M, int N, int G_, int c_) { nM = M / BM; nN = N / BM; nwg = nM * nN; G = G_; c = c_; }
    __host__ __device__ bool next(int i, Unit& u) const {
        const long L = (long)i * G + c; if (L >= nwg) return false;
        int wgid = (int)L; { const int q = nwg / NXCD, r = nwg % NXCD, xcd = wgid % NXCD, off = wgid / NXCD; wgid = (xcd < r ? xcd * (q + 1) : r * (q + 1) + (xcd - r) * q) + off; }
        const int nig = WGM * nN, gid = wgid / nig, fm = gid * WGM, gsz = (nM - fm) < WGM ? (nM - fm) : WGM;
        u.pm = fm + ((wgid % nig) % gsz); u.pn = (wgid % nig) / gsz; return true;
    }
    __device__ __forceinline__ void a_ready(const Unit&) const {}
    __device__ __forceinline__ void done(const Unit&) const {}
};

__device__ __forceinline__ unsigned cvt_pk_bf16(float lo, float hi) { unsigned r; asm volatile("v_cvt_pk_bf16_f32 %0, %1, %2" : "=v"(r) : "v"(lo), "v"(hi)); return r; }
__device__ __forceinline__ float sigm(float x) { return __builtin_amdgcn_rcpf(1.0f + __builtin_amdgcn_exp2f(-1.4426950408889634f * x)); }
__device__ __forceinline__ float bflo(unsigned u) { return __uint_as_float(u << 16); }
__device__ __forceinline__ float bfhi(unsigned u) { return __uint_as_float(u & 0xffff0000u); }
struct EpiZ {
    static constexpr bool PERM = true, AFTER_DRAIN = false, HAS_MID = false;
    bf16_t* Z; float* G;
    __device__ __forceinline__ void operator()(const f32x4 (&acc)[2][2][4][2], const Unit& u, int wr, int wc, int fr, int fq) const {
        const int row0 = u.pm * BM + wr * 64 + fr; const int colt = u.pn * BM + wc * 32 + 8 * fq;
        if (u.pn < 19) {
            const bool sg = u.pn >= 11;
#pragma unroll
            for (int ai = 0; ai < 2; ++ai)
#pragma unroll
                for (int m = 0; m < 4; ++m) { bf16_t* rowp = Z + (size_t)(row0 + ai * HALF + m * 16) * ZW + colt;
#pragma unroll
                    for (int bj = 0; bj < 2; ++bj) { f32x4 v0 = acc[ai][bj][m][0], v1 = acc[ai][bj][m][1];
                        if (sg) { v0 = (f32x4){sigm(v0[0]), sigm(v0[1]), sigm(v0[2]), sigm(v0[3])}; v1 = (f32x4){sigm(v1[0]), sigm(v1[1]), sigm(v1[2]), sigm(v1[3])}; }
                        u32x4 w; w.x = cvt_pk_bf16(v0[0], v0[1]); w.y = cvt_pk_bf16(v0[2], v0[3]); w.z = cvt_pk_bf16(v1[0], v1[1]); w.w = cvt_pk_bf16(v1[2], v1[3]);
                        *(u32x4*)(rowp + bj * HALF) = w; } }
        } else if (wc == 0 && fq < 3) {
#pragma unroll
            for (int ai = 0; ai < 2; ++ai)
#pragma unroll
                for (int m = 0; m < 4; ++m) { float* gp = G + (size_t)(row0 + ai * HALF + m * 16) * 24 + 8 * fq; const f32x4 v0 = acc[ai][0][m][0], v1 = acc[ai][0][m][1];
                    *(f32x4*)gp = (f32x4){sigm(v0[0]), sigm(v0[1]), sigm(v0[2]), sigm(v0[3])}; *(f32x4*)(gp + 4) = (f32x4){sigm(v1[0]), sigm(v1[1]), sigm(v1[2]), sigm(v1[3])}; }
        }
    }
};
__device__ __forceinline__ float gclamp(float g) { return g > 1.0e-20f ? g : 1.0e-20f; }
struct EpiUpF {
    static constexpr bool PERM = true, AFTER_DRAIN = false, HAS_MID = true;
    bf16_t* Y; const bf16_t* Zg;
    __device__ __forceinline__ void mid(f32x4 (&acc)[2][2][4][2], const Unit& u, int wr, int wc, int fr, int fq) const {
        int row0 = u.pm * BM + wr * 64 + fr; int colt = u.pn * BM + wc * 32 + 8 * fq;
        asm volatile("" : "+v"(row0), "+v"(colt));
#pragma unroll
        for (int ai = 0; ai < 2; ++ai)
#pragma unroll
            for (int m = 0; m < 4; ++m) { const size_t row = (size_t)(row0 + ai * HALF + m * 16);
#pragma unroll
                for (int bj = 0; bj < 2; ++bj) { const int col = colt + bj * HALF;
                    const u32x4 ga = *(const u32x4*)(Zg + row * ZW + ZMA + col), gb = *(const u32x4*)(Zg + row * ZW + ZMB + col);
                    f32x4& a0 = acc[ai][bj][m][0]; f32x4& a1 = acc[ai][bj][m][1];
                    a0[0] *= bflo(ga.x) * __builtin_amdgcn_rcpf(gclamp(bflo(gb.x))); a0[1] *= bfhi(ga.x) * __builtin_amdgcn_rcpf(gclamp(bfhi(gb.x)));
                    a0[2] *= bflo(ga.y) * __builtin_amdgcn_rcpf(gclamp(bflo(gb.y))); a0[3] *= bfhi(ga.y) * __builtin_amdgcn_rcpf(gclamp(bfhi(gb.y)));
                    a1[0] *= bflo(ga.z) * __builtin_amdgcn_rcpf(gclamp(bflo(gb.z))); a1[1] *= bfhi(ga.z) * __builtin_amdgcn_rcpf(gclamp(bfhi(gb.z)));
                    a1[2] *= bflo(ga.w) * __builtin_amdgcn_rcpf(gclamp(bflo(gb.w))); a1[3] *= bfhi(ga.w) * __builtin_amdgcn_rcpf(gclamp(bfhi(gb.w))); }
                if (m & 1) asm volatile("" ::: "memory"); }
    }
    __device__ __forceinline__ void operator()(const f32x4 (&acc)[2][2][4][2], const Unit& u, int wr, int wc, int fr, int fq) const {
        const int row0 = u.pm * BM + wr * 64 + fr; const int colt = u.pn * BM + wc * 32 + 8 * fq;
#pragma unroll
        for (int ai = 0; ai < 2; ++ai)
#pragma unroll
            for (int m = 0; m < 4; ++m) { const size_t row = (size_t)(row0 + ai * HALF + m * 16);
#pragma unroll
                for (int bj = 0; bj < 2; ++bj) { const int col = colt + bj * HALF; const u32x4 gt = *(const u32x4*)(Zg + row * ZW + ZMB + col);
                    const f32x4 a0 = acc[ai][bj][m][0], a1 = acc[ai][bj][m][1];
                    u32x4 w; w.x = cvt_pk_bf16(a0[0] * gclamp(bflo(gt.x)), a0[1] * gclamp(bfhi(gt.x))); w.y = cvt_pk_bf16(a0[2] * gclamp(bflo(gt.y)), a0[3] * gclamp(bfhi(gt.y)));
                    w.z = cvt_pk_bf16(a1[0] * gclamp(bflo(gt.z)), a1[1] * gclamp(bfhi(gt.z))); w.w = cvt_pk_bf16(a1[2] * gclamp(bflo(gt.w)), a1[3] * gclamp(bfhi(gt.w)));
                    *(u32x4*)(Y + row * DM + col) = w; }
                if (m & 1) asm volatile("" ::: "memory"); }
    }
};
struct EpiRes {
    static constexpr bool PERM = true, AFTER_DRAIN = false, HAS_MID = false;
    const float* base; float* out; const float* gate;
    __device__ __forceinline__ void operator()(const f32x4 (&acc)[2][2][4][2], const Unit& u, int wr, int wc, int fr, int fq) const {
        const int row0 = u.pm * BM + wr * 64 + fr; const int colt = u.pn * BM + wc * 32 + 8 * fq; const int b = (u.pm * BM) >> 12;
        f32x4 bv[2][4];
#define ER_LOAD(buf, k_) do { const int bj_ = (k_) >> 2, ai_ = ((k_) >> 1) & 1, n_ = (k_) & 1; _Pragma("unroll") for (int m = 0; m < 4; ++m) bv[buf][m] = *(const f32x4*)(base + (size_t)(row0 + ai_ * HALF + m * 16) * DM + colt + bj_ * HALF + 4 * n_); } while (0)
        ER_LOAD(0, 0);
#pragma unroll
        for (int k = 0; k < 8; ++k) { const int bj = k >> 2, ai = (k >> 1) & 1, n = k & 1, cb = k & 1;
            if (k + 1 < 8) ER_LOAD(cb ^ 1, k + 1);
            const f32x4 g = *(const f32x4*)(gate + (size_t)b * 6144 + colt + bj * HALF + 4 * n);
            asm volatile("" ::: "memory");
#pragma unroll
            for (int m = 0; m < 4; ++m) *(f32x4*)(out + (size_t)(row0 + ai * HALF + m * 16) * DM + colt + bj * HALF + 4 * n) = bv[cb][m] + g * acc[ai][bj][m][n];
            asm volatile("" ::: "memory"); }
#undef ER_LOAD
    }
};
struct EpiRelu2 {
    static constexpr bool PERM = true, AFTER_DRAIN = false, HAS_MID = false;
    bf16_t* H;
    __device__ __forceinline__ void operator()(const f32x4 (&acc)[2][2][4][2], const Unit& u, int wr, int wc, int fr, int fq) const {
        const int row0 = u.pm * BM + wr * 64 + fr; const int colt = u.pn * BM + wc * 32 + 8 * fq;
#pragma unroll
        for (int ai = 0; ai < 2; ++ai)
#pragma unroll
            for (int m = 0; m < 4; ++m) { bf16_t* rowp = H + (size_t)(row0 + ai * HALF + m * 16) * FF + colt;
#pragma unroll
                for (int bj = 0; bj < 2; ++bj) { f32x4 v0 = acc[ai][bj][m][0], v1 = acc[ai][bj][m][1];
                    v0 = __builtin_elementwise_max(v0, (f32x4){0.f, 0.f, 0.f, 0.f}); v1 = __builtin_elementwise_max(v1, (f32x4){0.f, 0.f, 0.f, 0.f}); v0 = v0 * v0; v1 = v1 * v1;
                    u32x4 w; w.x = cvt_pk_bf16(v0[0], v0[1]); w.y = cvt_pk_bf16(v0[2], v0[3]); w.z = cvt_pk_bf16(v1[0], v1[1]); w.w = cvt_pk_bf16(v1[2], v1[3]);
                    *(u32x4*)(rowp + bj * HALF) = w; } }
    }
};
struct EpiRes2 {
    static constexpr bool PERM = true, AFTER_DRAIN = false, HAS_MID = false;
    const float* base; float* out; const float* gate; const float* g2; const float* scale2; bf16_t* XN2; float* rowss;
    __device__ __forceinline__ void operator()(const f32x4 (&acc)[2][2][4][2], const Unit& u, int wr, int wc, int fr, int fq) const {
        const int row0 = u.pm * BM + wr * 64 + fr; const int colt = u.pn * BM + wc * 32 + 8 * fq; const int b = (u.pm * BM) >> 12;
        float ss[8];
#pragma unroll
        for (int r = 0; r < 8; ++r) ss[r] = 0.f;
#pragma unroll
        for (int bj = 0; bj < 2; ++bj) { const int c = colt + bj * HALF;
            const f32x4 gt0 = *(const f32x4*)(gate + (size_t)b * 6144 + c), gt1 = *(const f32x4*)(gate + (size_t)b * 6144 + c + 4);
            const f32x4 gm0 = *(const f32x4*)(g2 + c) * (*(const f32x4*)(scale2 + (size_t)b * 6144 + c) + 1.0f), gm1 = *(const f32x4*)(g2 + c + 4) * (*(const f32x4*)(scale2 + (size_t)b * 6144 + c + 4) + 1.0f);
#pragma unroll
            for (int ai = 0; ai < 2; ++ai) {
                f32x4 bv[4][2];
#pragma unroll
                for (int m = 0; m < 4; ++m) { const size_t off = (size_t)(row0 + ai * HALF + m * 16) * DM + c; bv[m][0] = *(const f32x4*)(base + off); bv[m][1] = *(const f32x4*)(base + off + 4); }
                asm volatile("" ::: "memory");
#pragma unroll
                for (int m = 0; m < 4; ++m) { const size_t off = (size_t)(row0 + ai * HALF + m * 16) * DM + c;
                    const f32x4 h0 = bv[m][0] + gt0 * acc[ai][bj][m][0], h1 = bv[m][1] + gt1 * acc[ai][bj][m][1];
                    *(f32x4*)(out + off) = h0; *(f32x4*)(out + off + 4) = h1;
                    ss[ai * 4 + m] += (h0[0] * h0[0] + h0[1] * h0[1]) + (h0[2] * h0[2] + h0[3] * h0[3]) + (h1[0] * h1[0] + h1[1] * h1[1]) + (h1[2] * h1[2] + h1[3] * h1[3]);
                    const f32x4 v0 = h0 * gm0, v1 = h1 * gm1;
                    u32x4 w; w.x = cvt_pk_bf16(v0[0], v0[1]); w.y = cvt_pk_bf16(v0[2], v0[3]); w.z = cvt_pk_bf16(v1[0], v1[1]); w.w = cvt_pk_bf16(v1[2], v1[3]);
                    *(u32x4*)(XN2 + off) = w; }
                asm volatile("" ::: "memory"); } }
#pragma unroll
        for (int r = 0; r < 8; ++r) { float s = ss[r]; s += __shfl_xor(s, 16); s += __shfl_xor(s, 32);
            if (fq == 0) atomicAdd(rowss + row0 + (r >> 2) * HALF + (r & 3) * 16, s); }
    }
};
struct EpiRelu2N {
    static constexpr bool PERM = true, AFTER_DRAIN = false, HAS_MID = false;
    bf16_t* H; const float* rowss; const float* sw;
    __device__ __forceinline__ void operator()(const f32x4 (&acc)[2][2][4][2], const Unit& u, int wr, int wc, int fr, int fq) const {
        const int row0 = u.pm * BM + wr * 64 + fr; const int colt = u.pn * BM + wc * 32 + 8 * fq; const int b = (u.pm * BM) >> 12;
        float rstd[8];
#pragma unroll
        for (int r = 0; r < 8; ++r) rstd[r] = __builtin_amdgcn_rsqf(rowss[row0 + (r >> 2) * HALF + (r & 3) * 16] * (1.0f / DM) + 1e-6f);
#pragma unroll
        for (int bj = 0; bj < 2; ++bj) { const f32x4 sv0 = *(const f32x4*)(sw + (size_t)b * FF + colt + bj * HALF), sv1 = *(const f32x4*)(sw + (size_t)b * FF + colt + bj * HALF + 4);
#pragma unroll
            for (int ai = 0; ai < 2; ++ai)
#pragma unroll
                for (int m = 0; m < 4; ++m) { bf16_t* rowp = H + (size_t)(row0 + ai * HALF + m * 16) * FF + colt + bj * HALF;
                    f32x4 v0 = acc[ai][bj][m][0] * rstd[ai * 4 + m] + sv0, v1 = acc[ai][bj][m][1] * rstd[ai * 4 + m] + sv1;
                    v0 = __builtin_elementwise_max(v0, (f32x4){0.f, 0.f, 0.f, 0.f}); v1 = __builtin_elementwise_max(v1, (f32x4){0.f, 0.f, 0.f, 0.f}); v0 = v0 * v0; v1 = v1 * v1;
                    u32x4 w; w.x = cvt_pk_bf16(v0[0], v0[1]); w.y = cvt_pk_bf16(v0[2], v0[3]); w.z = cvt_pk_bf16(v1[0], v1[1]); w.w = cvt_pk_bf16(v1[2], v1[3]);
                    *(u32x4*)rowp = w; } }
    }
};
template <class Epi, class Sched, bool ALIGN_EPI = false, bool SP2 = false>
__device__ __forceinline__ void gemm_phase(PG8_LAS unsigned char* lds, const Gemm g, const Sched& S, const Epi& E) {
    int tid_ = threadIdx.x; asm volatile("" : "+v"(tid_));
    const int tid = tid_, wid = __builtin_amdgcn_readfirstlane(tid >> 6), lane = tid & 63, wr = wid >> 2, wc = wid & 3, fr = lane & 15, fq = lane >> 4;
    const int K = g.K, nt = K / BK;
    unsigned voffA[2], voffB[2];
#pragma unroll
    for (int i = 0; i < 2; ++i) { int R, C; stage_rc(tid * 16 + i * 8192, R, C); const int Rb = Epi::PERM ? ((R & ~31) + perm32(R & 31)) : R;
        voffA[i] = (unsigned)(R * K + C) * 2u; voffB[i] = (unsigned)(Rb * K + C) * 2u; }
    const size_t kstep = (size_t)(BK * 2);
    const size_t hstep = (size_t)HALF * K * 2;
    const size_t tstep = 2 * hstep;
    const unsigned ldsw = (unsigned)wid * 1024u;
    const int aoff = lds_byte(wr * 64 + fr, fq * 8), boff = lds_byte(wc * 32 + fr, fq * 8);
#define PG8_SA(b, h) (((b) * 2 + (h)) * HTB)
#define PG8_SB(b, h) ((4 + (b) * 2 + (h)) * HTB)
#define PG8_STAGE(bufoff, gbase, voff) do { _Pragma("unroll") for (int _i = 0; _i < 2; ++_i) \
        __builtin_amdgcn_global_load_lds((const unsigned*)((const char*)(gbase) + (voff)[_i]), (PG8_LAS unsigned*)(lds + (bufoff) + ldsw + _i * 8192), 16, 0, 0); } while (0)
#define PG8_LDA(dst, b, h) do { _Pragma("unroll") for (int m = 0; m < 4; ++m) _Pragma("unroll") for (int k = 0; k < 2; ++k) dst[m][k] = *(const PG8_LAS bf16x8*)(lds + PG8_SA(b, h) + aoff + m * 2048 + k * 1024); } while (0)
#define PG8_LDB(dst, b, h) do { _Pragma("unroll") for (int n = 0; n < 2; ++n) _Pragma("unroll") for (int k = 0; k < 2; ++k) dst[n][k] = *(const PG8_LAS bf16x8*)(lds + PG8_SB(b, h) + boff + n * 2048 + k * 1024); } while (0)
#define PG8_MMA(ai, bj, At, Bt) do { __builtin_amdgcn_s_setprio(1); _Pragma("unroll") for (int m = 0; m < 4; ++m) _Pragma("unroll") for (int n = 0; n < 2; ++n) _Pragma("unroll") for (int k = 0; k < 2; ++k) \
        acc[ai][bj][m][n] = __builtin_amdgcn_mfma_f32_16x16x32_bf16(Bt[n][k], At[m][k], acc[ai][bj][m][n], 0, 0, 0); __builtin_amdgcn_s_setprio(0); } while (0)
#define PG8_WAIT_V(n) asm volatile("s_waitcnt vmcnt(" #n ")" ::: "memory")
#define PG8_WAIT_L(n) asm volatile("s_waitcnt lgkmcnt(" #n ")" ::: "memory")
#define PG8_BAR __builtin_amdgcn_s_barrier()
#define PG8_SCHED __builtin_amdgcn_sched_barrier(0)
    Unit cur, nxt; int ui = 0;
    if (!S.next(0, cur)) return;
    f32x4 acc[2][2][4][2];
#pragma unroll
    for (int a = 0; a < 2; ++a)
#pragma unroll
        for (int b = 0; b < 2; ++b)
#pragma unroll
            for (int m = 0; m < 4; ++m)
#pragma unroll
                for (int n = 0; n < 2; ++n) acc[a][b][m][n] = (f32x4){0.f, 0.f, 0.f, 0.f};
    bf16x8 At[4][2], B0[2][2], B1[2][2];
    const char* cA = (const char*)g.A + (size_t)cur.pm * tstep; const char* cB = (const char*)g.Bt + (size_t)cur.pn * tstep;
    S.a_ready(cur);
    if constexpr (SP2) {
        PG8_STAGE(PG8_SB(0, 0), cB, voffB); PG8_STAGE(PG8_SB(0, 1), cB + hstep, voffB); PG8_STAGE(PG8_SA(0, 0), cA, voffA); PG8_STAGE(PG8_SA(0, 1), cA + hstep, voffA);
        if (wr == 1) PG8_BAR;
        PG8_WAIT_V(2); PG8_BAR;
        PG8_STAGE(PG8_SB(1, 0), cB + kstep, voffB); PG8_STAGE(PG8_SA(1, 0), cA + kstep, voffA); PG8_STAGE(PG8_SB(1, 1), cB + hstep + kstep, voffB);
        PG8_WAIT_V(6); PG8_BAR;
    } else {
        PG8_STAGE(PG8_SB(0, 0), cB, voffB); PG8_STAGE(PG8_SA(0, 0), cA, voffA); PG8_STAGE(PG8_SB(0, 1), cB + hstep, voffB); PG8_STAGE(PG8_SA(0, 1), cA + hstep, voffA);
        if (wr == 1) PG8_BAR;
        PG8_WAIT_V(4); PG8_BAR;
        PG8_STAGE(PG8_SB(1, 0), cB + kstep, voffB); PG8_STAGE(PG8_SA(1, 0), cA + kstep, voffA); PG8_STAGE(PG8_SB(1, 1), cB + hstep + kstep, voffB);
        PG8_WAIT_V(6); PG8_BAR;
    }
    for (;;) {
        const bool has_next = S.next(ui + 1, nxt);
        const char* nA = has_next ? (const char*)g.A + (size_t)nxt.pm * tstep : cA; const char* nB = has_next ? (const char*)g.Bt + (size_t)nxt.pn * tstep : cB;
        for (int t = 0; t < nt; t += 2) {
            if constexpr (Epi::HAS_MID) { if (t == nt / 2) E.mid(acc, cur, wr, wc, fr, fq); }
            const bool last = (t == nt - 2);
            const char* a1 = cA + (size_t)(t + 1) * kstep;
            const char* a2 = last ? nA : cA + (size_t)(t + 2) * kstep; const char* b2 = last ? nB : cB + (size_t)(t + 2) * kstep;
            const char* a3 = a2 + kstep; const char* b3 = b2 + kstep;
            if (last && has_next) S.a_ready(nxt);
            if constexpr (SP2) {
            PG8_LDB(B0, 0, 0); PG8_LDB(B1, 0, 1); PG8_SCHED; PG8_LDA(At, 0, 0); PG8_STAGE(PG8_SA(1, 1), a1 + hstep, voffA);
            PG8_WAIT_V(8); PG8_WAIT_L(0); PG8_BAR; PG8_MMA(0, 0, At, B0); PG8_MMA(0, 1, At, B1); PG8_BAR; PG8_SCHED;
            PG8_LDA(At, 0, 1); PG8_STAGE(PG8_SB(0, 0), b2, voffB); PG8_STAGE(PG8_SB(0, 1), b2 + hstep, voffB); PG8_STAGE(PG8_SA(0, 0), a2, voffA);
            PG8_WAIT_V(8); PG8_WAIT_L(0); PG8_BAR; PG8_MMA(1, 0, At, B0); PG8_MMA(1, 1, At, B1); PG8_BAR; PG8_SCHED;
            PG8_LDB(B0, 1, 0); PG8_LDB(B1, 1, 1); PG8_SCHED; PG8_LDA(At, 1, 0); PG8_STAGE(PG8_SA(0, 1), a2 + hstep, voffA);
            PG8_WAIT_V(8); PG8_WAIT_L(0); PG8_BAR; PG8_MMA(0, 0, At, B0); PG8_MMA(0, 1, At, B1); PG8_BAR; PG8_SCHED;
            PG8_LDA(At, 1, 1); PG8_STAGE(PG8_SB(1, 0), b3, voffB); PG8_STAGE(PG8_SB(1, 1), b3 + hstep, voffB); PG8_STAGE(PG8_SA(1, 0), a3, voffA);
            PG8_WAIT_V(8); PG8_WAIT_L(0); PG8_BAR; PG8_MMA(1, 0, At, B0); PG8_MMA(1, 1, At, B1); PG8_BAR; PG8_SCHED;
            } else {
            PG8_LDB(B0, 0, 0); PG8_SCHED; PG8_LDA(At, 0, 0); PG8_STAGE(PG8_SA(1, 1), a1 + hstep, voffA);
            PG8_WAIT_L(8); PG8_BAR; PG8_WAIT_L(0); PG8_MMA(0, 0, At, B0); PG8_BAR; PG8_SCHED;
            PG8_LDB(B1, 0, 1); PG8_STAGE(PG8_SB(0, 0), b2, voffB);
            PG8_BAR; PG8_WAIT_L(0); PG8_MMA(0, 1, At, B1); PG8_BAR;
            PG8_LDA(At, 0, 1); PG8_STAGE(PG8_SA(0, 0), a2, voffA);
            PG8_BAR; PG8_WAIT_L(0); PG8_MMA(1, 0, At, B0); PG8_BAR; PG8_SCHED;
            PG8_STAGE(PG8_SB(0, 1), b2 + hstep, voffB);
            PG8_WAIT_V(6); PG8_BAR; PG8_MMA(1, 1, At, B1); PG8_BAR;
            PG8_LDB(B0, 1, 0); PG8_SCHED; PG8_LDA(At, 1, 0); PG8_STAGE(PG8_SA(0, 1), a2 + hstep, voffA);
            PG8_WAIT_L(8); PG8_BAR; PG8_WAIT_L(0); PG8_MMA(0, 0, At, B0); PG8_BAR; PG8_SCHED;
            PG8_LDB(B1, 1, 1); PG8_STAGE(PG8_SB(1, 0), b3, voffB);
            PG8_BAR; PG8_WAIT_L(0); PG8_MMA(0, 1, At, B1); PG8_BAR;
            PG8_LDA(At, 1, 1); PG8_STAGE(PG8_SA(1, 0), a3, voffA);
            PG8_BAR; PG8_WAIT_L(0); PG8_MMA(1, 0, At, B0); PG8_BAR; PG8_SCHED;
            PG8_STAGE(PG8_SB(1, 1), b3 + hstep, voffB);
            PG8_WAIT_V(6); PG8_BAR; PG8_MMA(1, 1, At, B1); PG8_BAR;
            }
        }
        if constexpr (ALIGN_EPI) { if (wr == 0) PG8_BAR; }
        if constexpr (!Epi::AFTER_DRAIN) { E(acc, cur, wr, wc, fr, fq); S.done(cur); }
        if (!has_next) break;
#pragma unroll
        for (int a = 0; a < 2; ++a)
#pragma unroll
            for (int b = 0; b < 2; ++b)
#pragma unroll
                for (int m = 0; m < 4; ++m)
#pragma unroll
                    for (int n = 0; n < 2; ++n) acc[a][b][m][n] = (f32x4){0.f, 0.f, 0.f, 0.f};
        cur = nxt; cA = nA; cB = nB; ++ui;
        if constexpr (ALIGN_EPI) { if (wr == 1) PG8_BAR; }
    }
    PG8_WAIT_V(0);
    if constexpr (!ALIGN_EPI) { if (wr == 0) PG8_BAR; }
    PG8_BAR;
    if constexpr (Epi::AFTER_DRAIN) { E.fused(acc, cur, wr, wc, fr, fq, lds, wid, lane); S.done(cur); }
#undef PG8_SA
#undef PG8_SB
#undef PG8_STAGE
#undef PG8_LDA
#undef PG8_LDB
#undef PG8_MMA
#undef PG8_WAIT_V
#undef PG8_WAIT_L
#undef PG8_BAR
#undef PG8_SCHED
}
}

#define LAS __attribute__((address_space(3)))
typedef unsigned short bf16;
typedef unsigned v4u __attribute__((ext_vector_type(4)));
typedef unsigned v2u __attribute__((ext_vector_type(2)));
typedef float f32x4 __attribute__((ext_vector_type(4)));
typedef float f32x16 __attribute__((ext_vector_type(16)));
typedef short bf16x8 __attribute__((ext_vector_type(8)));
typedef float f32x2_t __attribute__((ext_vector_type(2)));
typedef __bf16 bf16x2_t __attribute__((ext_vector_type(2)));
#define LDS_WAIT() asm volatile("s_waitcnt lgkmcnt(0)" ::: "memory")
constexpr int LDS_BYTES = 147456;
constexpr int NWAVES = 8;

struct Params { const float* in[20]; float* out; unsigned char* ws; };

__device__ __forceinline__ unsigned pk2(float lo, float hi) { f32x2_t v = {lo, hi}; bf16x2_t b = __builtin_convertvector(v, bf16x2_t); return __builtin_bit_cast(unsigned, b); }
__device__ __forceinline__ float bflo(unsigned u) { return __uint_as_float(u << 16); }
__device__ __forceinline__ float bfhi(unsigned u) { return __uint_as_float(u & 0xffff0000u); }
__device__ __forceinline__ float ex2(float x) { return __builtin_amdgcn_exp2f(x); }
__device__ __forceinline__ float lg2(float x) { return __builtin_amdgcn_logf(x); }
__device__ __forceinline__ float rcp(float x) { return __builtin_amdgcn_rcpf(x); }
__device__ __forceinline__ float sigm(float x) { return rcp(1.0f + ex2(-LOG2E * x)); }
__device__ __forceinline__ float wave_sum(float v) {
#pragma unroll
    for (int o = 1; o < 64; o <<= 1) v += __shfl_xor(v, o);
    return v;
}

__device__ __forceinline__ void transpose_item(const float* W, int ldw, int K, int ncols, bf16* WT, int row_off, LAS float* scr, int item, int lane) {
    const int nblk = ncols / 32, kb = item / nblk, nb = item % nblk, k0 = 64 * kb, n0 = 32 * nb;
    float tv[32];
#pragma unroll
    for (int i = 0; i < 32; ++i) { const int kk = 2 * i + (lane >> 5); tv[i] = W[(size_t)(k0 + kk) * ldw + n0 + (lane & 31)]; }
#pragma unroll
    for (int i = 0; i < 32; ++i) { const int kk = 2 * i + (lane >> 5); scr[kk * 33 + (lane & 31)] = tv[i]; }
    LDS_WAIT();
    const int c = lane & 7;
#pragma unroll
    for (int j = 0; j < 4; ++j) { const int n = (lane >> 3) + 8 * j; const LAS float* s = scr + (8 * c) * 33 + n;
        v4u o; o.x = pk2(s[0 * 33], s[1 * 33]); o.y = pk2(s[2 * 33], s[3 * 33]); o.z = pk2(s[4 * 33], s[5 * 33]); o.w = pk2(s[6 * 33], s[7 * 33]);
        *(v4u*)(WT + (size_t)(row_off + n0 + n) * K + k0 + 8 * c) = o; }
    LDS_WAIT();
}

__device__ __forceinline__ void transpose_item_kp(const float* W, int ldw, int K, int ncols, bf16* WT, int dpitch, int koff, LAS float* scr, int item, int lane) {
    const int nblk = ncols / 32, kb = item / nblk, nb = item % nblk, k0 = 64 * kb, n0 = 32 * nb;
    float tv[32];
#pragma unroll
    for (int i = 0; i < 32; ++i) { const int kk = 2 * i + (lane >> 5); tv[i] = W[(size_t)(k0 + kk) * ldw + n0 + (lane & 31)]; }
#pragma unroll
    for (int i = 0; i < 32; ++i) { const int kk = 2 * i + (lane >> 5); scr[kk * 33 + (lane & 31)] = tv[i]; }
    LDS_WAIT();
    const int c = lane & 7;
#pragma unroll
    for (int j = 0; j < 4; ++j) { const int n = (lane >> 3) + 8 * j; const LAS float* s = scr + (8 * c) * 33 + n;
        v4u o; o.x = pk2(s[0 * 33], s[1 * 33]); o.y = pk2(s[2 * 33], s[3 * 33]); o.z = pk2(s[4 * 33], s[5 * 33]); o.w = pk2(s[6 * 33], s[7 * 33]);
        *(v4u*)(WT + (size_t)(n0 + n) * dpitch + koff + k0 + 8 * c) = o; }
    LDS_WAIT();
}

__device__ __forceinline__ void phase0(const Params& p, LAS unsigned char* lds, int tid, int lane, int wave) {
    unsigned char* ws = p.ws;
    { float* rowss = (float*)(ws + WS_ROWSS); for (int e = blockIdx.x * 512 + tid; e < M; e += gridDim.x * 512) rowss[e] = 0.f; }
    LAS float* scr = (LAS float*)(lds + wave * 16384);
    const int gw = blockIdx.x * NWAVES + wave, NGW = gridDim.x * NWAVES;
    const float* w_in = p.in[7];
    bf16* Win_t = (bf16*)(ws + WS_WIN);
    constexpr int I0 = 16 * 40, I1 = 16 * 48, I2 = 16 * 32, I3 = 16 * 32, I4 = 8 * 32, I5 = 8 * 32, I6 = 16 * 32, I7 = 16 * 128, I8 = 64 * 32, I9 = 32 * 2, I10 = 32 * 2;
    constexpr int NITEMS = I0 + I1 + I2 + I3 + I4 + I5 + I6 + I7 + I8 + I9 + I10;
    for (int it = gw; it < NITEMS; it += NGW) {
        int r = it;
        if (r < I0) { transpose_item(w_in, 4888, DM, 1280, Win_t, 0, scr, r, lane); continue; } r -= I0;
        if (r < I1) { transpose_item(w_in + 1304, 4888, DM, 1536, Win_t, 1280, scr, r, lane); continue; } r -= I1;
        if (r < I2) { transpose_item(w_in + 2840, 4888, DM, 1024, Win_t, 2816, scr, r, lane); continue; } r -= I2;
        if (r < I3) { transpose_item(w_in + 3864, 4888, DM, 1024, Win_t, 3840, scr, r, lane); continue; } r -= I3;
        if (r < I4) { transpose_item_kp(p.in[15], DM, 512, DM, (bf16*)(ws + WS_WUPA), DM, 0, scr, r, lane); continue; } r -= I4;
        if (r < I5) { transpose_item_kp(p.in[16], DM, 512, DM, (bf16*)(ws + WS_WUPA), DM, 512, scr, r, lane); continue; } r -= I5;
        if (r < I6) { transpose_item(p.in[17], DM, DM, DM, (bf16*)(ws + WS_WOUT), 0, scr, r, lane); continue; } r -= I6;
        if (r < I7) { transpose_item(p.in[18], FF, DM, FF, (bf16*)(ws + WS_W1), 0, scr, r, lane); continue; } r -= I7;
        if (r < I8) { transpose_item(p.in[19], DM, FF, DM, (bf16*)(ws + WS_W2), 0, scr, r, lane); continue; } r -= I8;
        if (r < I9) { transpose_item(p.in[9], 64, 2048, 64, (bf16*)(ws + WS_CW1K), 0, scr, r, lane); continue; } r -= I9;
        transpose_item(p.in[11], 64, 2048, 64, (bf16*)(ws + WS_CW1V), 0, scr, r, lane);
    }
    __syncthreads();
    LAS float* sc = (LAS float*)lds;
    LAS float* red = (LAS float*)(lds + 65536);
    float* mod = (float*)(ws + WS_MOD);
    for (int it = blockIdx.x; it < 247; it += gridDim.x) {
        if (it < 192) {
            const float* c = p.in[1]; const float* ada_w = p.in[3]; const float* ada_b = p.in[4];
            for (int e = tid; e < 16384; e += 512) { const float v = c[e]; sc[e] = v * sigm(v); }
            __syncthreads();
            const int colj = tid & 31, kg = tid >> 5, j0 = it * 32;
            float acc[16];
#pragma unroll
            for (int b = 0; b < 16; ++b) acc[b] = 0.f;
            for (int k8 = kg * 64; k8 < kg * 64 + 64; k8 += 8) {
                float w[8];
#pragma unroll
                for (int u = 0; u < 8; ++u) w[u] = ada_w[(size_t)(k8 + u) * 6144 + j0 + colj];
#pragma unroll
                for (int u = 0; u < 8; ++u)
#pragma unroll
                    for (int b = 0; b < 16; ++b) acc[b] += sc[b * 1024 + k8 + u] * w[u];
            }
#pragma unroll
            for (int b = 0; b < 16; ++b) red[(kg * 16 + b) * 32 + colj] = acc[b];
            __syncthreads();
            { const int b = tid >> 5, cj = tid & 31; float s = ada_b[j0 + cj];
#pragma unroll
              for (int k2 = 0; k2 < 16; ++k2) s += red[(k2 * 16 + b) * 32 + cj];
              mod[b * 6144 + j0 + cj] = s; }
            __syncthreads();
        } else if (it < 194) {
            const int kv = it - 192; const float* w1 = kv ? p.in[11] : p.in[9]; const float* pos = p.in[8];
            const int colj = tid & 63, kg = tid >> 6; float a = 0.f;
            for (int k16 = kg * 256; k16 < kg * 256 + 256; k16 += 16) {
                float w[16], pv_[16];
#pragma unroll
                for (int u = 0; u < 16; ++u) { w[u] = w1[(k16 + u) * 64 + colj]; pv_[u] = pos[k16 + u]; }
#pragma unroll
                for (int u = 0; u < 16; ++u) a += pv_[u] * w[u];
            }
            red[kg * 64 + colj] = a;
            __syncthreads();
            if (tid < 64) { float s = 0.f;
#pragma unroll
                for (int k2 = 0; k2 < 8; ++k2) s += red[k2 * 64 + tid];
                ((float*)(ws + WS_PW1))[kv * 64 + tid] = s; }
            __syncthreads();
        } else if (it < 218) {
            const int r = it - 194;
            for (int k = tid; k < 1024; k += 512) Win_t[(size_t)(4864 + r) * 1024 + k] = (bf16)(pk2(w_in[(size_t)k * 4888 + 1280 + r], 0.f) & 0xffffu);
        } else {
            v4u* zp = (v4u*)(Win_t + (size_t)(4888 + 8 * (it - 218)) * 1024);
            for (int e = tid; e < 8 * 1024 / 8; e += 512) zp[e] = (v4u){0u, 0u, 0u, 0u};
        }
    }
}

__device__ __forceinline__ void norm_rows(const float* src, const float* gain, const float* mod, int shift_off, int scale_off, bf16* dst, int lane, int wave) {
    const int gw = blockIdx.x * NWAVES + wave, NGW = gridDim.x * NWAVES;
    const int rpw = (M + NGW - 1) / NGW;
    const int m0 = gw * rpw, m1 = (m0 + rpw < M) ? m0 + rpw : M;
    if (m0 >= M) return;
    f32x4 gam[4], sh[4];
    int bcur = -1;
    f32x4 v[4], nx[4];
    { const f32x4* xr = (const f32x4*)(src + (size_t)m0 * DM) + lane;
#pragma unroll
      for (int j = 0; j < 4; ++j) nx[j] = xr[64 * j]; }
    for (int m = m0; m < m1; ++m) {
        const int b = m >> 12;
        if (b != bcur) { bcur = b;
#pragma unroll
            for (int j = 0; j < 4; ++j) { const int col = 4 * (lane + 64 * j);
                const f32x4 g = *(const f32x4*)(gain + col), sc = *(const f32x4*)(mod + b * 6144 + scale_off + col); sh[j] = *(const f32x4*)(mod + b * 6144 + shift_off + col);
                gam[j] = g * (sc + 1.0f); } }
#pragma unroll
        for (int j = 0; j < 4; ++j) v[j] = nx[j];
        if (m + 1 < m1) { const f32x4* xr = (const f32x4*)(src + (size_t)(m + 1) * DM) + lane;
#pragma unroll
            for (int j = 0; j < 4; ++j) nx[j] = xr[64 * j]; }
        float ss = 0.f;
#pragma unroll
        for (int j = 0; j < 4; ++j) ss += (v[j].x * v[j].x + v[j].y * v[j].y) + (v[j].z * v[j].z + v[j].w * v[j].w);
        const float rstd = rsqrtf(wave_sum(ss) * (1.0f / DM) + 1e-6f);
#pragma unroll
        for (int j = 0; j < 4; ++j) { const int col = 4 * (lane + 64 * j);
            const f32x4 u = (v[j] * rstd) * gam[j] + sh[j];
            v2u w; w.x = pk2(u.x, u.y); w.y = pk2(u.z, u.w);
            *(v2u*)(dst + (size_t)m * DM + col) = w; }
    }
}

__device__ __forceinline__ void phase3(const Params& p, LAS unsigned char* lds, int tid, int lane, int wave, bool do_norm) {
    unsigned char* ws = p.ws;
    bf16* Z = (bf16*)(ws + WS_Z);
    const int gw = blockIdx.x * NWAVES + wave, NGW = gridDim.x * NWAVES;
    {
        LAS float* hid = (LAS float*)(lds + wave * 4352);
        const int row = lane & 15, quad = lane >> 4;
        for (int task = (NGW - 1 - gw); task < 1024; task += NGW) {
            const int kv = task & 1, cg16 = (task >> 1) & 15, hkv = (task >> 5) & 1, b = task >> 6;
            const int c0 = cg16 * 16;
            const bf16* w1t = (const bf16*)(ws + (kv ? WS_CW1V : WS_CW1K));
            const float* pw1 = (const float*)(ws + WS_PW1) + kv * 64;
            const float* w2 = kv ? p.in[12] : p.in[10];
            const int zc = (kv ? ZVC : ZKC) + hkv * 64;
            int t0 = 16 * (c0 + row);
            f32x4 acc[4];
#pragma unroll
            for (int nt = 0; nt < 4; ++nt) acc[nt] = (f32x4){0.f, 0.f, 0.f, 0.f};
#pragma unroll 8
            for (int s = 0; s < 64; ++s) {
                int tk = t0 + (s >> 1); tk = tk < S ? tk : S - 1;
                const bf16x8 a = *(const bf16x8*)(Z + ((size_t)b * S + tk) * ZW + zc + (s & 1) * 32 + quad * 8);
#pragma unroll
                for (int nt = 0; nt < 4; ++nt) { const bf16x8 bb = *(const bf16x8*)(w1t + (size_t)(nt * 16 + row) * 2048 + s * 32 + quad * 8);
                    acc[nt] = __builtin_amdgcn_mfma_f32_16x16x32_bf16(a, bb, acc[nt], 0, 0, 0); }
            }
#pragma unroll
            for (int nt = 0; nt < 4; ++nt) { const float pb = pw1[nt * 16 + row];
#pragma unroll
                for (int j = 0; j < 4; ++j) { const float x = acc[nt][j] + pb; hid[(quad * 4 + j) * 68 + nt * 16 + row] = x * sigm(x); } }
            LDS_WAIT();
            float o[16];
#pragma unroll
            for (int r = 0; r < 16; ++r) o[r] = 0.f;
            for (int k = 0; k < 64; k += 4) {
                const float wa = w2[(k + 0) * 64 + lane], wb = w2[(k + 1) * 64 + lane], wc_ = w2[(k + 2) * 64 + lane], wd = w2[(k + 3) * 64 + lane];
#pragma unroll
                for (int r = 0; r < 16; ++r) { const f32x4 h = *(const LAS f32x4*)(hid + r * 68 + k); o[r] += h.x * wa + h.y * wb + h.z * wc_ + h.w * wd; }
            }
            LDS_WAIT();
            if (kv == 0) {
                const float gn = p.in[14][lane];
                bf16* KC = (bf16*)(ws + WS_KC) + ((size_t)(b * 2 + hkv) * 256 + c0) * 64 + lane;
#pragma unroll
                for (int r = 0; r < 16; ++r) { const float ss = wave_sum(o[r] * o[r]); const float rstd = rsqrtf(ss * (1.0f / 64.0f) + 1e-6f);
                    const float v = (c0 + r < 255) ? o[r] * rstd * gn : 0.f; KC[r * 64] = (bf16)(pk2(v, 0.f) & 0xffffu); }
            } else {
                bf16* VCT = (bf16*)(ws + WS_VCT) + ((size_t)(b * 2 + hkv) * 64 + lane) * 256 + c0;
                if (c0 + 15 >= 255) o[15] = 0.f;
                v4u w0, w1;
                w0.x = pk2(o[0], o[1]); w0.y = pk2(o[2], o[3]); w0.z = pk2(o[8], o[9]); w0.w = pk2(o[10], o[11]);
                w1.x = pk2(o[4], o[5]); w1.y = pk2(o[6], o[7]); w1.z = pk2(o[12], o[13]); w1.w = pk2(o[14], o[15]);
                *(v4u*)VCT = w0; *(v4u*)(VCT + 8) = w1;
            }
        }
    }
    __syncthreads();
    if (do_norm) {
        const float* qg = p.in[13]; const float* kg = p.in[14];
        const int sub = lane & 7;
        const long total = (long)M * 12;
        if (gw < NGW / 2)
        for (long base = (long)gw * 32; base < total; base += (long)(NGW / 2) * 32) {
            v4u raw[4]; v4u* ptr[4]; const float* gnp[4]; float extra[4];
#pragma unroll
            for (int u = 0; u < 4; ++u) {
                const long vi = base + u * 8 + (lane >> 3);
                const int tokn = (int)(vi / 12), which = (int)(vi - (long)tokn * 12);
                int col; extra[u] = 1.0f;
                if (which < 8) { col = ZQ + which * 64; gnp[u] = qg; extra[u] = 0.125f * LOG2E; }
                else if (which < 10) { col = ZKS + (which - 8) * 64; gnp[u] = kg + 64; }
                else { col = ZKW + (which - 10) * 64; gnp[u] = kg + 128; }
                ptr[u] = (v4u*)(Z + (size_t)tokn * ZW + col + sub * 8);
                raw[u] = *ptr[u];
            }
#pragma unroll
            for (int u = 0; u < 4; ++u) {
                const v4u rw = raw[u];
                float f[8] = {bflo(rw.x), bfhi(rw.x), bflo(rw.y), bfhi(rw.y), bflo(rw.z), bfhi(rw.z), bflo(rw.w), bfhi(rw.w)};
                float ss = 0.f;
#pragma unroll
                for (int e2 = 0; e2 < 8; ++e2) ss += f[e2] * f[e2];
                ss += __shfl_xor(ss, 1); ss += __shfl_xor(ss, 2); ss += __shfl_xor(ss, 4);
                const float rstd = rsqrtf(ss * (1.0f / 64.0f) + 1e-6f) * extra[u];
                const f32x4 g0 = *(const f32x4*)(gnp[u] + sub * 8), g1 = *(const f32x4*)(gnp[u] + sub * 8 + 4);
                v4u o; o.x = pk2(f[0] * rstd * g0.x, f[1] * rstd * g0.y); o.y = pk2(f[2] * rstd * g0.z, f[3] * rstd * g0.w);
                o.z = pk2(f[4] * rstd * g1.x, f[5] * rstd * g1.y); o.w = pk2(f[6] * rstd * g1.z, f[7] * rstd * g1.w);
                *ptr[u] = o;
            }
        }
    }
    __syncthreads();
    { LAS float* shl = (LAS float*)lds; const float* mod = (const float*)(ws + WS_MOD); const bf16* W1t = (const bf16*)(ws + WS_W1); float* sw = (float*)(ws + WS_SW);
      for (int e = tid; e < 16384; e += 512) shl[e] = mod[(e >> 10) * 6144 + 3072 + (e & 1023)];
      __syncthreads();
      for (int colx = gw; colx < FF; colx += NGW) {
          const v4u wa = *(const v4u*)(W1t + (size_t)colx * DM + lane * 16), wb = *(const v4u*)(W1t + (size_t)colx * DM + lane * 16 + 8);
          const float wv[16] = {bflo(wa.x), bfhi(wa.x), bflo(wa.y), bfhi(wa.y), bflo(wa.z), bfhi(wa.z), bflo(wa.w), bfhi(wa.w), bflo(wb.x), bfhi(wb.x), bflo(wb.y), bfhi(wb.y), bflo(wb.z), bfhi(wb.z), bflo(wb.w), bfhi(wb.w)};
          float res = 0.f;
#pragma unroll 1
          for (int bb = 0; bb < 16; ++bb) { float a = 0.f;
#pragma unroll
              for (int e4 = 0; e4 < 4; ++e4) { const f32x4 s4 = *(const LAS f32x4*)(shl + bb * 1024 + lane * 16 + e4 * 4); a += s4.x * wv[4 * e4] + s4.y * wv[4 * e4 + 1] + s4.z * wv[4 * e4 + 2] + s4.w * wv[4 * e4 + 3]; }
              a = wave_sum(a); if (lane == bb) res = a; }
          if (lane < 16) sw[(size_t)lane * FF + colx] = res;
      } }
}

constexpr int NSTG = 4, STG_BYTES = 16384, LUT_OFF = 65536, ACC_OFF = 69632, MISC4_OFF = 135168, LUT2_OFF = 137728;
#define MFMA32(a, b, c) __builtin_amdgcn_mfma_f32_32x32x16_bf16((a), (b), (c), 0, 0, 0)
#define KKOF(hf, r) (32 * (hf) + ((r) & 3) + 8 * ((r) >> 2))
constexpr float NEGBIG = -1.0e30f;

__device__ __forceinline__ void glds16(const void* gsrc, unsigned lds_dst) {
    unsigned keep;
    asm volatile("s_mov_b32 %0, m0\n\ts_mov_b32 m0, %2\n\ts_nop 0\n\tglobal_load_lds_dwordx4 %1, off\n\ts_mov_b32 m0, %0" : "=&s"(keep) : "v"(gsrc), "s"(lds_dst) : "memory");
}
#define WAITV_BAR(N) asm volatile("s_waitcnt vmcnt(" #N ")\n\ts_barrier" ::: "memory")
#define RING_WAIT(ahead) do { if ((ahead) >= 2) WAITV_BAR(4); else if ((ahead) == 1) WAITV_BAR(2); else WAITV_BAR(0); } while (0)
#define RING_WAIT4(ahead) do { if ((ahead) >= 2) WAITV_BAR(8); else if ((ahead) == 1) WAITV_BAR(4); else WAITV_BAR(0); } while (0)
#define RING_DRAIN() asm volatile("s_waitcnt vmcnt(0)" ::: "memory")

struct Ring {
    int r8, c8; unsigned base;
    __device__ __forceinline__ void init(LAS unsigned char* lds, int lane, int wave) { r8 = 8 * wave + (lane >> 3); c8 = (lane & 7) ^ ((lane >> 3) & 7); base = (unsigned)(uintptr_t)lds + (unsigned)wave * 1024u; }
    __device__ __forceinline__ void issue4(const bf16* k, const bf16* v, size_t pitch, int stage) const {
        const size_t o = (size_t)r8 * pitch + c8 * 8; const unsigned d = base + (unsigned)stage * (2u * STG_BYTES);
        glds16(k + o, (unsigned)__builtin_amdgcn_readfirstlane(d));
        glds16(v + o, (unsigned)__builtin_amdgcn_readfirstlane(d + 8192u));
        glds16(k + o + 64, (unsigned)__builtin_amdgcn_readfirstlane(d + 16384u));
        glds16(v + o + 64, (unsigned)__builtin_amdgcn_readfirstlane(d + 24576u));
    }
    __device__ __forceinline__ void issue(const bf16* k, size_t kpitch, const bf16* vt, size_t vpitch, int stage) const {
        glds16(k + (size_t)r8 * kpitch + c8 * 8, (unsigned)__builtin_amdgcn_readfirstlane(base + (unsigned)stage * STG_BYTES));
        glds16(vt + (size_t)r8 * vpitch + c8 * 8, (unsigned)__builtin_amdgcn_readfirstlane(base + (unsigned)stage * STG_BYTES + 8192u));
    }
};

__device__ __forceinline__ void qk_tile(const LAS unsigned char* kb, const bf16x8 (&qf)[4], int col, int hi, f32x16& s0, f32x16& s1, float cinit) {
    const LAS unsigned char* k0 = kb + col * 128; const int k7 = col & 7;
    bf16x8 a0[4], a1[4];
#pragma unroll
    for (int d0 = 0; d0 < 4; ++d0) { const int off = ((2 * d0 + hi) ^ k7) << 4; a0[d0] = *(const LAS bf16x8*)(k0 + off); a1[d0] = *(const LAS bf16x8*)(k0 + 32 * 128 + off); }
    asm volatile("" ::: "memory");
    f32x16 c;
#pragma unroll
    for (int r = 0; r < 16; ++r) c[r] = cinit;
    s0 = MFMA32(a0[0], qf[0], c); s1 = MFMA32(a1[0], qf[0], c);
#pragma unroll
    for (int d0 = 1; d0 < 4; ++d0) { s0 = MFMA32(a0[d0], qf[d0], s0); s1 = MFMA32(a1[d0], qf[d0], s1); }
}
__device__ __forceinline__ void qk_half_c(const LAS unsigned char* kb, const bf16x8 (&qf)[4], int col, int hi, int hf, f32x16& s, const f32x16& c) {
    const LAS unsigned char* k0 = kb + (32 * hf + col) * 128; const int k7 = col & 7;
    bf16x8 a[4];
#pragma unroll
    for (int d0 = 0; d0 < 4; ++d0) a[d0] = *(const LAS bf16x8*)(k0 + (((2 * d0 + hi) ^ k7) << 4));
    asm volatile("" ::: "memory");
    s = MFMA32(a[0], qf[0], c);
#pragma unroll
    for (int d0 = 1; d0 < 4; ++d0) s = MFMA32(a[d0], qf[d0], s);
}
__device__ __forceinline__ void qk_half(const LAS unsigned char* kb, const bf16x8 (&qf)[4], int col, int hi, int hf, f32x16& s, float cinit) {
    f32x16 c;
#pragma unroll
    for (int r = 0; r < 16; ++r) c[r] = cinit;
    qk_half_c(kb, qf, col, hi, hf, s, c);
}
__device__ __forceinline__ void pv_half(const LAS unsigned char* vb, const unsigned (&pw)[8], int col, int hi, int hf, f32x16& o0, f32x16& o1, f32x16& os, bf16x8 ones) {
    const LAS unsigned char* v0 = vb + col * 128; const int k7 = col & 7;
    bf16x8 a[2], bq[2];
#pragma unroll
    for (int s2 = 0; s2 < 2; ++s2) { const int e = ((2 * (2 * hf + s2) + hi) ^ k7) << 4; a[s2] = *(const LAS bf16x8*)(v0 + e); bq[s2] = *(const LAS bf16x8*)(v0 + 32 * 128 + e); }
    asm volatile("" ::: "memory");
#pragma unroll
    for (int s2 = 0; s2 < 2; ++s2) {
        const v4u pu = {pw[4 * s2], pw[4 * s2 + 1], pw[4 * s2 + 2], pw[4 * s2 + 3]};
        const bf16x8 pf = __builtin_bit_cast(bf16x8, pu);
        o0 = MFMA32(a[s2], pf, o0);
        o1 = MFMA32(bq[s2], pf, o1);
        os = MFMA32(ones, pf, os);
    }
}
__device__ __forceinline__ void pv_tile(const LAS unsigned char* vb, const unsigned (&pw)[16], int col, int hi, f32x16& o0, f32x16& o1) {
    const LAS unsigned char* v0 = vb + col * 128; const int k7 = col & 7;
#pragma unroll
    for (int sl = 0; sl < 4; ++sl) {
        const v4u pu = {pw[4 * sl], pw[4 * sl + 1], pw[4 * sl + 2], pw[4 * sl + 3]};
        const bf16x8 pf = __builtin_bit_cast(bf16x8, pu);
        const int e = ((2 * sl + hi) ^ k7) << 4;
        const bf16x8 a = *(const LAS bf16x8*)(v0 + e), bq = *(const LAS bf16x8*)(v0 + 32 * 128 + e);
        o0 = MFMA32(a, pf, o0);
        o1 = MFMA32(bq, pf, o1);
    }
}
typedef short v4i16_t __attribute__((ext_vector_type(4)));
__device__ __forceinline__ v2u vtr8(const LAS unsigned char* p) { return __builtin_bit_cast(v2u, __builtin_amdgcn_ds_read_tr16_b64_v4i16((LAS v4i16_t*)p)); }
struct TrAddr { int base0, ch0, ch1; };
__device__ __forceinline__ TrAddr tr_addr(int lane) {
    const int h = lane >> 5, blk = (lane >> 4) & 1, q = (lane & 15) >> 2, pp = lane & 3, r7 = 4 * h + q;
    TrAddr a; a.base0 = r7 * 128 + 8 * (pp & 1); a.ch0 = ((2 * blk + (pp >> 1)) ^ r7) << 4; a.ch1 = ((4 + 2 * blk + (pp >> 1)) ^ r7) << 4; return a;
}
__device__ __forceinline__ void pv_half_tr(const LAS unsigned char* vb, const unsigned (&pw)[8], const TrAddr& ta, int hf, f32x16& o0, f32x16& o1, f32x16& os, bf16x8 ones) {
    const LAS unsigned char* v0 = vb + ta.base0;
    v2u a0[2], a1[2], b0[2], b1[2];
#pragma unroll
    for (int s2 = 0; s2 < 2; ++s2) { const int ro = (2 * hf + s2) * 2048;
        a0[s2] = vtr8(v0 + ro + ta.ch0); a1[s2] = vtr8(v0 + ro + 1024 + ta.ch0); b0[s2] = vtr8(v0 + ro + ta.ch1); b1[s2] = vtr8(v0 + ro + 1024 + ta.ch1); }
#pragma unroll
    for (int s2 = 0; s2 < 2; ++s2) {
        const v4u pu = {pw[4 * s2], pw[4 * s2 + 1], pw[4 * s2 + 2], pw[4 * s2 + 3]};
        const bf16x8 pf = __builtin_bit_cast(bf16x8, pu);
        const v4u au = {a0[s2].x, a0[s2].y, a1[s2].x, a1[s2].y}, bu = {b0[s2].x, b0[s2].y, b1[s2].x, b1[s2].y};
        o0 = MFMA32(__builtin_bit_cast(bf16x8, au), pf, o0);
        o1 = MFMA32(__builtin_bit_cast(bf16x8, bu), pf, o1);
        os = MFMA32(ones, pf, os);
    }
}
__device__ __forceinline__ void pv_tile_tr(const LAS unsigned char* vb, const unsigned (&pw)[16], const TrAddr& ta, f32x16& o0, f32x16& o1) {
    const LAS unsigned char* v0 = vb + ta.base0;
#pragma unroll
    for (int sl = 0; sl < 4; ++sl) {
        const v4u pu = {pw[4 * sl], pw[4 * sl + 1], pw[4 * sl + 2], pw[4 * sl + 3]};
        const bf16x8 pf = __builtin_bit_cast(bf16x8, pu);
        const v2u a0 = vtr8(v0 + sl * 2048 + ta.ch0), a1 = vtr8(v0 + sl * 2048 + 1024 + ta.ch0), b0 = vtr8(v0 + sl * 2048 + ta.ch1), b1 = vtr8(v0 + sl * 2048 + 1024 + ta.ch1);
        const v4u au = {a0.x, a0.y, a1.x, a1.y}, bu = {b0.x, b0.y, b1.x, b1.y};
        o0 = MFMA32(__builtin_bit_cast(bf16x8, au), pf, o0);
        o1 = MFMA32(__builtin_bit_cast(bf16x8, bu), pf, o1);
    }
}
#define PACK_P(pw, s0, s1) do { _Pragma("unroll") for (int r_ = 0; r_ < 8; ++r_) { pw[r_] = pk2(s0[2 * r_], s0[2 * r_ + 1]); pw[8 + r_] = pk2(s1[2 * r_], s1[2 * r_ + 1]); } } while (0)
__device__ __forceinline__ int msb64(unsigned long long x) { return 63 - __builtin_clzll(x); }

__device__ __forceinline__ void nsa_unit(const Params& p, LAS unsigned char* lds, int b, int hkv, int i, int tid, int lane, int wave) {
    asm volatile("" : "+v"(tid)); lane = tid & 63;
    unsigned char* ws = p.ws;
    const bf16* Z = (const bf16*)(ws + WS_Z);
    const int col = lane & 31, hi = lane >> 5, g = col >> 3, qp = col & 7;
    const int tq = 8 * wave + qp, t = 64 * i + tq, head = 4 * hkv + g;
    const size_t tok = (size_t)b * S + t;
    const LAS float* lut = (const LAS float*)(lds + LUT_OFF) + head * 128;
    const float bias_far = lut[127];
    LAS float* impw = (LAS float*)(lds + ACC_OFF + wave * 8192);
    LAS float* impw3 = impw + 512;
    LAS float* accs = (LAS float*)(lds + ACC_OFF + wave * 8192) + lane;
    LAS unsigned long long* selor = (LAS unsigned long long*)(lds + MISC4_OFF);
    Ring rg; rg.init(lds, lane, wave);
    const TrAddr tra = tr_addr(lane);
    bf16x8 qf[4];
#pragma unroll
    for (int d0 = 0; d0 < 4; ++d0) qf[d0] = *(const bf16x8*)(Z + tok * ZW + ZQ + head * 64 + d0 * 16 + hi * 8);
    const float* gates = (const float*)(ws + WS_G) + tok * 24 + hkv * 12 + g * 3;
    const float g_c = gates[0], g_s = gates[1], g_w = gates[2];
    const LAS float* pmisc = (const LAS float*)(lds + MISC4_OFF + 2304);
    const bool fastp = pmisc[2] != 0.f;
    float qnorm;
    { float q2 = 0.f;
#pragma unroll
      for (int d0 = 0; d0 < 4; ++d0) { const v4u u = __builtin_bit_cast(v4u, qf[d0]);
          q2 += bflo(u.x) * bflo(u.x) + bfhi(u.x) * bfhi(u.x) + bflo(u.y) * bflo(u.y) + bfhi(u.y) * bfhi(u.y) + bflo(u.z) * bflo(u.z) + bfhi(u.z) * bfhi(u.z) + bflo(u.w) * bflo(u.w) + bfhi(u.w) * bfhi(u.w); }
      q2 += __shfl_xor(q2, 32);
      qnorm = sqrtf(q2) * 1.002f; }
    const bf16* KC = (const bf16*)(ws + WS_KC) + (size_t)(b * 2 + hkv) * 256 * 64;
    const bf16* VCT = (const bf16*)(ws + WS_VCT) + (size_t)(b * 2 + hkv) * 64 * 256;
    const int ntc = (i >> 4) + 1;
    const int cbase = 64 * i + tq - 31 - 64 * hi;
    float m = NEGBIG, l = 0.f;
    RING_DRAIN();
    for (int k = 0; k < 3 && k < ntc; ++k) rg.issue(KC + (size_t)k * 64 * 64, 64, VCT + k * 64, 256, k);
    for (int it = 0; it < ntc; ++it) {
        const int ahead = ntc - 1 - it;
        RING_WAIT(ahead);
        if (it + 3 < ntc) rg.issue(KC + (size_t)(it + 3) * 64 * 64, 64, VCT + (it + 3) * 64, 256, (it + 3) & 3);
        f32x16 s0, s1;
        const bool allfar = (64 * i + 8 * wave - 31 - 1024 * it - 1008) >= 128;
        float mx = NEGBIG;
        if (allfar) {
            qk_tile(lds + (it & 3) * STG_BYTES, qf, col, hi, s0, s1, bias_far);
#pragma unroll
            for (int r = 0; r < 16; ++r) mx = fmaxf(mx, fmaxf(s0[r], s1[r]));
        } else {
            qk_tile(lds + (it & 3) * STG_BYTES, qf, col, hi, s0, s1, 0.f);
            const int db = cbase - 1024 * it;
#pragma unroll
            for (int r = 0; r < 16; ++r) {
                const int d0_ = db - 16 * KKOF(0, r), d1_ = db - 16 * KKOF(1, r);
                const float x0 = s0[r] + lut[min(max(d0_, 0), 127)], x1 = s1[r] + lut[min(max(d1_, 0), 127)];
                s0[r] = d0_ >= 0 ? x0 : NEGBIG; s1[r] = d1_ >= 0 ? x1 : NEGBIG;
                mx = fmaxf(mx, fmaxf(s0[r], s1[r]));
            }
        }
        mx = fmaxf(mx, __shfl_xor(mx, 32));
        const float mn = fmaxf(m, mx);
        float ps = 0.f;
#pragma unroll
        for (int r = 0; r < 16; ++r) { ps += (s0[r] > -1.0e29f ? ex2(s0[r] - mn) : 0.f) + (s1[r] > -1.0e29f ? ex2(s1[r] - mn) : 0.f); }
        l = l * ex2(m - mn) + ps; m = mn;
    }
    WAITV_BAR(0);
    l += __shfl_xor(l, 32);
    const float inv_lc = l > 0.f ? rcp(l) : 0.f;
    f32x16 oc0, oc1;
#pragma unroll
    for (int r = 0; r < 16; ++r) { oc0[r] = 0.f; oc1[r] = 0.f; }
    for (int it = 0; it < ntc; ++it) {
        f32x16 s0, s1;
        const bool allfar = (64 * i + 8 * wave - 31 - 1024 * it - 1008) >= 128;
        if (allfar) {
            qk_tile(lds + (it & 3) * STG_BYTES, qf, col, hi, s0, s1, bias_far - m);
#pragma unroll
            for (int r = 0; r < 16; ++r) { s0[r] = ex2(s0[r]) * inv_lc; s1[r] = ex2(s1[r]) * inv_lc; }
        } else {
            qk_tile(lds + (it & 3) * STG_BYTES, qf, col, hi, s0, s1, 0.f);
            const int db = cbase - 1024 * it;
#pragma unroll
            for (int r = 0; r < 16; ++r) {
                const int d0_ = db - 16 * KKOF(0, r), d1_ = db - 16 * KKOF(1, r);
                const float x0 = s0[r] + lut[min(max(d0_, 0), 127)], x1 = s1[r] + lut[min(max(d1_, 0), 127)];
                s0[r] = d0_ >= 0 ? ex2(x0 - m) * inv_lc : 0.f; s1[r] = d1_ >= 0 ? ex2(x1 - m) * inv_lc : 0.f;
            }
        }
#pragma unroll
        for (int k4 = 0; k4 < 4; ++k4) {
            float pa0 = (s0[4 * k4] + s0[4 * k4 + 1]) + (s0[4 * k4 + 2] + 0.5f * s0[4 * k4 + 3]), pc0 = 0.5f * s0[4 * k4 + 3];
            float pa1 = (s1[4 * k4] + s1[4 * k4 + 1]) + (s1[4 * k4 + 2] + 0.5f * s1[4 * k4 + 3]), pc1 = 0.5f * s1[4 * k4 + 3];
            pa0 += __shfl_xor(pa0, 8); pa0 += __shfl_xor(pa0, 16); pc0 += __shfl_xor(pc0, 8); pc0 += __shfl_xor(pc0, 16);
            pa1 += __shfl_xor(pa1, 8); pa1 += __shfl_xor(pa1, 16); pc1 += __shfl_xor(pc1, 8); pc1 += __shfl_xor(pc1, 16);
            if (g == 0) { const int n0 = 16 * it + 2 * k4 + hi;
                impw[qp * 64 + n0] = pa0; impw3[qp * 64 + n0] = pc0; impw[qp * 64 + n0 + 8] = pa1; impw3[qp * 64 + n0 + 8] = pc1; }
        }
        unsigned pw[16]; PACK_P(pw, s0, s1);
        pv_tile(lds + (it & 3) * STG_BYTES + 8192, pw, col, hi, oc0, oc1);
    }
    LDS_WAIT();
    unsigned long long mysel = 0ull, wsel = 0ull;
    {
        const unsigned long long curmask = (i == 63) ? ~0ull : ((1ull << (i + 1)) - 1ull);
        const int want = i + 1 < 16 ? i + 1 : 16;
        const int n = lane;
        LAS float* vbuf = (LAS float*)(lds + MISC4_OFF + 256 + wave * 256);
        for (int q = 0; q < 8; ++q) {
            float v = impw[q * 64 + n] + (n > 0 ? impw3[q * 64 + n - 1] : 0.f) + ((n == 0 || n == i || n == i - 1) ? 1.0e4f : 0.f);
            v = (n <= i) ? v : -1.0e9f;
            vbuf[n] = v;
            LDS_WAIT();
            int cgt = 0;
#pragma unroll
            for (int m4 = 0; m4 < 16; ++m4) { const f32x4 w = *(const LAS f32x4*)(vbuf + 4 * m4); cgt += (w.x > v ? 1 : 0) + (w.y > v ? 1 : 0) + (w.z > v ? 1 : 0) + (w.w > v ? 1 : 0); }
            LDS_WAIT();
            unsigned long long sel = __ballot(cgt < 16) & curmask;
            if (__builtin_popcountll(sel) != want) {
                int rank = 0;
#pragma unroll 8
                for (int mm = 0; mm < 64; ++mm) { const float vm = vbuf[mm]; rank += (vm > v || (vm == v && mm < n)) ? 1 : 0; }
                LDS_WAIT();
                sel = __ballot(rank < 16) & curmask;
            }
            if (qp == q) mysel = sel;
            wsel |= sel;
        }
    }
    LDS_WAIT();
#pragma unroll
    for (int r = 0; r < 16; ++r) { accs[r * 64] = oc0[r] * g_c; accs[(16 + r) * 64] = oc1[r] * g_c; }
    if (lane == 0) selor[wave] = wsel;
    __syncthreads();
    unsigned long long U = 0ull;
#pragma unroll
    for (int w = 0; w < 8; ++w) U |= selor[w];
    U = ((unsigned long long)__builtin_amdgcn_readfirstlane((unsigned)(U >> 32)) << 32) | (unsigned long long)__builtin_amdgcn_readfirstlane((unsigned)U);
    const v4u onesu = {0x3f803f80u, 0x3f803f80u, 0x3f803f80u, 0x3f803f80u};
    const bf16x8 ones = __builtin_bit_cast(bf16x8, onesu);
    constexpr float THR = 8.0f;
#pragma unroll 1
    for (int mode = 0; mode < 2; ++mode) {
        const bf16* Kb = Z + (size_t)b * S * ZW + (mode ? ZKW : ZKS) + hkv * 64;
        const bf16* Vb = Z + (size_t)b * S * ZW + (mode ? ZVW : ZVS) + hkv * 64;
        unsigned long long Tm;
        if (mode == 0) Tm = U;
        else { const int jlo = i >= 8 ? i - 8 : 0; const unsigned long long hm = (i == 63) ? ~0ull : ((1ull << (i + 1)) - 1ull); Tm = hm & ~((1ull << jlo) - 1ull); }
        const unsigned long long wm = mode ? Tm : wsel;
        const unsigned long long lm = mode ? Tm : mysel;
        const int dmax = mode ? 512 : 0x40000000;
        f32x16 o0, o1, os, cfar;
#pragma unroll
        for (int r = 0; r < 16; ++r) { o0[r] = 0.f; o1[r] = 0.f; os[r] = 0.f; }
        float mref = fastp ? qnorm * pmisc[mode] + pmisc[8 + head] : 0.f;
#pragma unroll
        for (int r = 0; r < 16; ++r) cfar[r] = bias_far - mref;
        const int nt = __builtin_popcountll(Tm);
        unsigned long long irem = Tm, crem = Tm;
        for (int k = 0; k < 3 && k < nt; ++k) { const int ji = msb64(irem); irem &= ~(1ull << ji); rg.issue(Kb + (size_t)ji * 64 * ZW, ZW, Vb + (size_t)ji * 64 * ZW, ZW, k); }
        if (fastp) {
        for (int it = 0; it < nt; ++it) {
            const int j = msb64(crem); crem &= ~(1ull << j);
            const int ahead = nt - 1 - it;
            RING_WAIT(ahead);
            if (it + 3 < nt) { const int ji = msb64(irem); irem &= ~(1ull << ji); rg.issue(Kb + (size_t)ji * 64 * ZW, ZW, Vb + (size_t)ji * 64 * ZW, ZW, (it + 3) & 3); }
                if ((wm >> j) & 1ull) {
                    const LAS unsigned char* stg = lds + (it & 3) * STG_BYTES;
                    const int dj = i - j;
                    const bool lsel = (lm >> j) & 1ull;
                    const int db = 64 * dj + tq - 4 * hi;
#pragma unroll
                    for (int hf = 0; hf < 2; ++hf) {
                        f32x16 s; unsigned pw[8];
                        if (dj <= 2) {
                            qk_half(stg, qf, col, hi, hf, s, -mref);
                            const LAS float* l2p = (const LAS float*)(lds + LUT2_OFF) + head * 260 + db + 5;
#pragma unroll
                            for (int r = 0; r < 16; ++r) { const float x = s[r] + l2p[63 - KKOF(hf, r)]; s[r] = (lsel && KKOF(hf, r) <= db) ? ex2(x) : 0.f; }
#pragma unroll
                            for (int r = 0; r < 8; ++r) pw[r] = pk2(s[2 * r], s[2 * r + 1]);
                        } else if (dj == 8) {
                            qk_half_c(stg, qf, col, hi, hf, s, cfar);
#pragma unroll
                            for (int r = 0; r < 16; ++r) { const int d_ = db - KKOF(hf, r); s[r] = (lsel && d_ < dmax) ? ex2(s[r]) : 0.f; }
#pragma unroll
                            for (int r = 0; r < 8; ++r) pw[r] = pk2(s[2 * r], s[2 * r + 1]);
                        } else {
                            qk_half_c(stg, qf, col, hi, hf, s, cfar);
#pragma unroll
                            for (int r = 0; r < 8; ++r) { const unsigned w_ = pk2(ex2(s[2 * r]), ex2(s[2 * r + 1])); pw[r] = lsel ? w_ : 0u; }
                        }
                        pv_half_tr(stg + 8192, pw, tra, hf, o0, o1, os, ones);
                    }
                }
        }
        } else {
        for (int it = 0; it < nt; ++it) {
            const int j = msb64(crem); crem &= ~(1ull << j);
            const int ahead = nt - 1 - it;
            RING_WAIT(ahead);
            if (it + 3 < nt) { const int ji = msb64(irem); irem &= ~(1ull << ji); rg.issue(Kb + (size_t)ji * 64 * ZW, ZW, Vb + (size_t)ji * 64 * ZW, ZW, (it + 3) & 3); }
            if ((wm >> j) & 1ull) {
                const LAS unsigned char* stg = lds + (it & 3) * STG_BYTES;
                const int dj = i - j;
                const bool nearb = dj <= 2;
                const bool lsel = (lm >> j) & 1ull;
                const int db = 64 * dj + tq - 4 * hi;
#pragma unroll
                for (int hf = 0; hf < 2; ++hf) {
                    f32x16 s;
                    float mx = NEGBIG;
                    if (nearb) {
                        qk_half(stg, qf, col, hi, hf, s, -mref);
#pragma unroll
                        for (int r = 0; r < 16; ++r) { const int d_ = db - KKOF(hf, r); const float x = s[r] + lut[min(max(d_, 0), 127)]; s[r] = (lsel && d_ >= 0) ? x : NEGBIG; mx = fmaxf(mx, s[r]); }
                    } else if (dj == 8) {
                        qk_half(stg, qf, col, hi, hf, s, bias_far - mref);
#pragma unroll
                        for (int r = 0; r < 16; ++r) { const int d_ = db - KKOF(hf, r); s[r] = (lsel && d_ < dmax) ? s[r] : NEGBIG; mx = fmaxf(mx, s[r]); }
                    } else {
                        qk_half(stg, qf, col, hi, hf, s, lsel ? bias_far - mref : NEGBIG);
#pragma unroll
                        for (int r = 0; r < 16; ++r) mx = fmaxf(mx, s[r]);
                    }
                    { auto rr_ = __builtin_amdgcn_permlane32_swap(__float_as_uint(mx), __float_as_uint(mx), false, false); mx = fmaxf(__uint_as_float(rr_[0]), __uint_as_float(rr_[1])); }
                    if (dj == 0 && hf == 0) {
                        mref = mx;
#pragma unroll
                        for (int r = 0; r < 16; ++r) s[r] -= mx;
                    } else if (__any(mx > THR)) {
                        const float dl = mx > THR ? mx : 0.f; mref += dl; const float scl = ex2(-dl);
#pragma unroll
                        for (int r = 0; r < 16; ++r) s[r] -= dl;
                        o0 = o0 * scl; o1 = o1 * scl; os = os * scl;
                    }
                    unsigned pw[8];
#pragma unroll
                    for (int r = 0; r < 8; ++r) pw[r] = pk2(ex2(s[2 * r]), ex2(s[2 * r + 1]));
                    pv_half_tr(stg + 8192, pw, tra, hf, o0, o1, os, ones);
                }
            }
        }
        }
        WAITV_BAR(0);
        l = os[0];
        const float f = (mode ? g_w : g_s) * (l > 0.f ? rcp(l) : 0.f);
        if (mode == 0) {
#pragma unroll
            for (int r = 0; r < 16; ++r) { accs[r * 64] += o0[r] * f; accs[(16 + r) * 64] += o1[r] * f; }
        } else {
            bf16* O = (bf16*)(ws + WS_ATTA) + tok * 1024 + head * 64 + 4 * hi;
#pragma unroll
            for (int r = 0; r < 16; ++r) { o0[r] = accs[r * 64] + o0[r] * f; o1[r] = accs[(16 + r) * 64] + o1[r] * f; }
#pragma unroll
            for (int k4 = 0; k4 < 4; ++k4) {
                v2u w0; w0.x = pk2(o0[4 * k4], o0[4 * k4 + 1]); w0.y = pk2(o0[4 * k4 + 2], o0[4 * k4 + 3]);
                v2u w1; w1.x = pk2(o1[4 * k4], o1[4 * k4 + 1]); w1.y = pk2(o1[4 * k4 + 2], o1[4 * k4 + 3]);
                *(v2u*)(O + 8 * k4) = w0; *(v2u*)(O + 32 + 8 * k4) = w1;
            }
        }
    }
}

template <bool MK> __device__ __forceinline__ void sb_scan(f32x16& s0, f32x16& s1, int db, int hi, float& R) {
            f32x16 k0, k1;
#pragma unroll
            for (int r = 0; r < 16; ++r) {
                const float e0 = ex2(fminf(s0[r], 80.f)), e1 = ex2(fminf(s1[r], 80.f));
                const float p0 = rcp(1.0f + e0), p1 = rcp(1.0f + e1);
                s0[r] = e0 * p0; s1[r] = e1 * p1;
                k0[r] = (!MK || KKOF(0, r) < db) ? p0 : 1.0f; k1[r] = (!MK || KKOF(1, r) < db) ? p1 : 1.0f;
            }
            float g4[8], pg[8], E[8];
#pragma unroll
            for (int k4 = 0; k4 < 4; ++k4) { g4[k4] = (k0[4 * k4] * k0[4 * k4 + 1]) * (k0[4 * k4 + 2] * k0[4 * k4 + 3]); g4[4 + k4] = (k1[4 * k4] * k1[4 * k4 + 1]) * (k1[4 * k4 + 2] * k1[4 * k4 + 3]); }
#pragma unroll
            for (int G = 0; G < 8; ++G) pg[G] = __shfl_xor(g4[G], 32);
            E[7] = 1.0f;
#pragma unroll
            for (int G = 6; G >= 0; --G) E[G] = E[G + 1] * (g4[G + 1] * pg[G + 1]);
            const float T = E[0] * (g4[0] * pg[0]);
#pragma unroll
            for (int G = 0; G < 8; ++G) {
                const float base = R * E[G] * (hi == 0 ? pg[G] : 1.0f);
                const int k4 = G & 3;
                if (G < 4) {
                    const float u3 = base, u2 = u3 * k0[4 * k4 + 3], u1 = u2 * k0[4 * k4 + 2], u0 = u1 * k0[4 * k4 + 1];
                    s0[4 * k4 + 3] = (!MK || KKOF(0, 4 * k4 + 3) < db) ? s0[4 * k4 + 3] * u3 : 0.f;
                    s0[4 * k4 + 2] = (!MK || KKOF(0, 4 * k4 + 2) < db) ? s0[4 * k4 + 2] * u2 : 0.f;
                    s0[4 * k4 + 1] = (!MK || KKOF(0, 4 * k4 + 1) < db) ? s0[4 * k4 + 1] * u1 : 0.f;
                    s0[4 * k4 + 0] = (!MK || KKOF(0, 4 * k4 + 0) < db) ? s0[4 * k4 + 0] * u0 : 0.f;
                } else {
                    const float u3 = base, u2 = u3 * k1[4 * k4 + 3], u1 = u2 * k1[4 * k4 + 2], u0 = u1 * k1[4 * k4 + 1];
                    s1[4 * k4 + 3] = (!MK || KKOF(1, 4 * k4 + 3) < db) ? s1[4 * k4 + 3] * u3 : 0.f;
                    s1[4 * k4 + 2] = (!MK || KKOF(1, 4 * k4 + 2) < db) ? s1[4 * k4 + 2] * u2 : 0.f;
                    s1[4 * k4 + 1] = (!MK || KKOF(1, 4 * k4 + 1) < db) ? s1[4 * k4 + 1] * u1 : 0.f;
                    s1[4 * k4 + 0] = (!MK || KKOF(1, 4 * k4 + 0) < db) ? s1[4 * k4 + 0] * u0 : 0.f;
                }
            }
            R *= T;
}

__device__ __forceinline__ void sb_unit(const Params& p, LAS unsigned char* lds, int b, int hp, int qb, int tid, int lane, int wave) {
    asm volatile("" : "+v"(tid)); lane = tid & 63;
    unsigned char* ws = p.ws;
    const bf16* Z = (const bf16*)(ws + WS_Z);
    const int col = lane & 31, hi = lane >> 5, w4 = wave & 3, hsel = wave >> 2, h = 2 * hp + hsel;
    const int t = 128 * qb + 32 * w4 + col;
    const size_t tok = (size_t)b * S + t;
    const int tmaxw = 128 * qb + 32 * w4 + 31;
    LAS int* flags = (LAS int*)(lds + MISC4_OFF + 128);
    Ring rg; rg.init(lds, lane, wave);
    bf16x8 qf[4];
#pragma unroll
    for (int d0 = 0; d0 < 4; ++d0) { const v4u raw = *(const v4u*)(Z + tok * ZW + ZQB + h * 64 + d0 * 16 + hi * 8);
        constexpr float QS = 0.125f * LOG2E;
        v4u sc; sc.x = pk2(bflo(raw.x) * QS, bfhi(raw.x) * QS); sc.y = pk2(bflo(raw.y) * QS, bfhi(raw.y) * QS);
        sc.z = pk2(bflo(raw.z) * QS, bfhi(raw.z) * QS); sc.w = pk2(bflo(raw.w) * QS, bfhi(raw.w) * QS);
        qf[d0] = __builtin_bit_cast(bf16x8, sc); }
    const bf16* Kb = Z + (size_t)b * S * ZW + ZKB + 2 * hp * 64;
    const bf16* Vb = Z + (size_t)b * S * ZW + ZVB + 2 * hp * 64;
    const TrAddr tra = tr_addr(lane);
    f32x16 o0, o1;
#pragma unroll
    for (int r = 0; r < 16; ++r) { o0[r] = 0.f; o1[r] = 0.f; }
    float R = 1.0f; bool dead = false;
    const int jtop = 2 * qb + 1, nt = jtop + 1;
    if (tid < 16) flags[tid] = 0;
    RING_DRAIN();
    for (int k = 0; k < 3 && k < nt; ++k) rg.issue4(Kb + (size_t)(jtop - k) * 64 * ZW, Vb + (size_t)(jtop - k) * 64 * ZW, ZW, k);
    for (int it = 0; it < nt; ++it) {
        const int j = jtop - it;
        const int ahead = nt - 1 - it;
        RING_WAIT4(ahead);
        if (it > 0) { int alld = 1;
#pragma unroll
            for (int w = 0; w < 8; ++w) alld &= flags[((it - 1) & 1) * 8 + w];
            if (alld) break; }
        if (it + 3 < nt) rg.issue4(Kb + (size_t)(j - 3) * 64 * ZW, Vb + (size_t)(j - 3) * 64 * ZW, ZW, (it + 3) & 3);
        if (!dead && 64 * j < tmaxw) {
            const LAS unsigned char* stg = lds + (it & 3) * (2 * STG_BYTES) + hsel * STG_BYTES;
            f32x16 s0, s1;
            qk_tile(stg, qf, col, hi, s0, s1, 0.f);
            const int db = t - 64 * j - 4 * hi;
            if (64 * j + 63 < tmaxw - 31) sb_scan<false>(s0, s1, db, hi, R); else sb_scan<true>(s0, s1, db, hi, R);
            unsigned pw[16]; PACK_P(pw, s0, s1);
            pv_tile_tr(stg + 8192, pw, tra, o0, o1);
            dead = __all(R < 1.0e-44f);
        }
        if (lane == 0) flags[(it & 1) * 8 + wave] = dead ? 1 : 0;
    }
    WAITV_BAR(0);
    bf16* O = (bf16*)(ws + WS_ATTA) + tok * 1024 + 512 + h * 64 + 4 * hi;
#pragma unroll
    for (int k4 = 0; k4 < 4; ++k4) {
        v2u w0; w0.x = pk2(o0[4 * k4], o0[4 * k4 + 1]); w0.y = pk2(o0[4 * k4 + 2], o0[4 * k4 + 3]);
        v2u w1; w1.x = pk2(o1[4 * k4], o1[4 * k4 + 1]); w1.y = pk2(o1[4 * k4 + 2], o1[4 * k4 + 3]);
        *(v2u*)(O + 8 * k4) = w0; *(v2u*)(O + 32 + 8 * k4) = w1;
    }
}

__device__ __forceinline__ void phase4(const Params& p, LAS unsigned char* lds, int tid, int lane, int wave) {
    for (int vb = blockIdx.x; vb < 256; vb += gridDim.x) {
    const int v = (vb & 7) * 32 + (vb >> 3);
    __syncthreads();
    { const float* rel = p.in[2]; LAS float* lut = (LAS float*)(lds + LUT_OFF);
      for (int e = tid; e < 1024; e += 512) { const int head = e >> 7, dist = e & 127;
          int bk = dist; if (dist >= 16) { bk = 16 + (int)(logf((float)dist / 16.0f) / 2.0794415416798357f * 16.0f); bk = bk < 31 ? bk : 31; }
          lut[e] = rel[bk * 8 + head] * LOG2E; } }
    __syncthreads();
    { const LAS float* lut = (const LAS float*)(lds + LUT_OFF); LAS float* l2 = (LAS float*)(lds + LUT2_OFF);
      for (int e = tid; e < 8 * 260; e += 512) { const int head = e / 260, d = e % 260 - 68; l2[e] = d < 0 ? 0.f : lut[head * 128 + (d < 127 ? d : 127)]; } }
    if (wave == 0) { const float* qg = p.in[13]; const float* kg = p.in[14]; LAS float* pm = (LAS float*)(lds + MISC4_OFF + 2304); const LAS float* lut = (const LAS float*)(lds + LUT_OFF);
        float a = fabsf(qg[lane]), b1 = fabsf(kg[64 + lane]), b2 = fabsf(kg[128 + lane]);
#pragma unroll
        for (int o = 1; o < 64; o <<= 1) { a = fmaxf(a, __shfl_xor(a, o)); b1 = fmaxf(b1, __shfl_xor(b1, o)); b2 = fmaxf(b2, __shfl_xor(b2, o)); }
        float bm = -1.0e30f, ball = 0.f;
        if (lane < 8) {
            for (int d = 0; d < 128; ++d) bm = fmaxf(bm, lut[lane * 128 + d]);
            pm[8 + lane] = bm; }
        ball = lane < 8 ? bm : -1.0e30f;
#pragma unroll
        for (int o = 1; o < 64; o <<= 1) ball = fmaxf(ball, __shfl_xor(ball, o));
        const float kn1 = 8.0f * b1 * 1.004f, kn2 = 8.0f * b2 * 1.004f, qmax = 8.0f * a * 0.125f * LOG2E * 1.004f;
        const float worst = qmax * fmaxf(kn1, kn2) + fmaxf(ball, 0.f);
        if (lane == 0) { pm[0] = kn1; pm[1] = kn2; pm[2] = (worst < 48.0f) ? 1.0f : 0.0f; } }
    __syncthreads();
        { const int pair = v >> 3, s = v & 7, b = pair >> 1, hkv = pair & 1;
#pragma unroll 1
          for (int u = 0; u < 8; ++u) { const int i = (u & 1) ? (16 * (u >> 1) + 15 - s) : (16 * (u >> 1) + s);
 for (int rep_ = 0; rep_ < REP_NSA; ++rep_) nsa_unit(p, lds, b, hkv, i, tid, lane, wave);
 } }
        { const int pair = v >> 2, b = pair >> 2, hp = pair & 3;
#pragma unroll 1
          for (int u = 0; u < 8; ++u) { const int qb = (v & 3) + 4 * u;
 for (int rep_ = 0; rep_ < REP_SB; ++rep_) sb_unit(p, lds, b, hp, qb, tid, lane, wave);
 } }
    }
}

#define XB_TMO      128
#define XB_XCNT(j)  (256  + 64 * (j))
#define XB_XSUB(j)  (1280 + 64 * (j))
#define XB_XGEN(j)  (2304 + 64 * (j))
#define XB_TOP      3328
#define XB_TOPGEN   3392
#define XCD_BAR_WORDS 3456
#define XB_SPIN_CAP (1u << 18)

__device__ __forceinline__ unsigned xb_ld(unsigned* p)              { return __hip_atomic_load(p, __ATOMIC_RELAXED, __HIP_MEMORY_SCOPE_AGENT); }
__device__ __forceinline__ unsigned xb_add(unsigned* p, unsigned v) { return __hip_atomic_fetch_add(p, v, __ATOMIC_RELAXED, __HIP_MEMORY_SCOPE_AGENT); }
__device__ __forceinline__ unsigned xb_xcc_id() { return (unsigned)__builtin_amdgcn_s_getreg((3 << 11) | 20) & 0xFu; }
#define XB_SPIN(cond, bar) do { unsigned _sp = 0; while (cond) { __builtin_amdgcn_s_sleep(1); \
    if ((++_sp & 255u) == 0u) { if (xb_ld(&(bar)[XB_TMO])) break; if (_sp > XB_SPIN_CAP) { atomicAdd(&(bar)[XB_TMO], 1u); break; } } } } while (0)

struct XcdBarrier {
    unsigned* bar; unsigned x;
    volatile LAS unsigned* st;
};

__device__ __forceinline__ XcdBarrier xcd_barrier_post(unsigned* bar, volatile LAS unsigned* st) {
    XcdBarrier b; b.bar = bar; b.x = xb_xcc_id(); b.st = st;
    if (threadIdx.x == 0) (void)xb_add(&bar[XB_XCNT(b.x)], 1u);
    return b;
}
__device__ __forceinline__ void xcd_barrier_complete(unsigned* bar, unsigned x, unsigned& nloc, unsigned& nx) {
    const unsigned G = gridDim.x * gridDim.y * gridDim.z;
    unsigned sum, cnt, mine, sp = 0u;
    for (;;) {
        sum = 0u; cnt = 0u; mine = 0u;
#pragma unroll
        for (unsigned j = 0; j < 16; ++j) { const unsigned c = xb_ld(&bar[XB_XCNT(j)]); sum += c; cnt += (c > 0u) ? 1u : 0u; mine = (j == x) ? c : mine; }
        if (sum == G) break;
        __builtin_amdgcn_s_sleep(1);
        if ((++sp & 255u) == 0u) { if (xb_ld(&bar[XB_TMO])) break; if (sp > XB_SPIN_CAP) { atomicAdd(&bar[XB_TMO], 1u); break; } }
    }
    nloc = mine > 0u ? mine : 1u; nx = cnt > 0u ? cnt : 1u;
}

__device__ __forceinline__ void xcd_barrier(const XcdBarrier& b) {
    asm volatile("s_waitcnt vmcnt(0)" ::: "memory");
    __syncthreads();
    if (threadIdx.x == 0) {
        unsigned* bar = b.bar;
        __builtin_amdgcn_s_waitcnt(0);
        unsigned nloc = b.st[0], nx = b.st[1];
        if (nloc == 0u) { xcd_barrier_complete(bar, b.x, nloc, nx); b.st[0] = nloc; b.st[1] = nx; }
        const unsigned old = xb_add(&bar[XB_XSUB(b.x)], 1u);
        const unsigned gen = old / nloc;
        if (old + 1u == (gen + 1u) * nloc) {
            __builtin_amdgcn_fence(__ATOMIC_RELEASE, "agent");
            asm volatile("s_waitcnt vmcnt(0)" ::: "memory");
            const unsigned og = xb_add(&bar[XB_TOP], 1u);
            const unsigned tg = og / nx;
            if (og + 1u == (tg + 1u) * nx) xb_add(&bar[XB_TOPGEN], 1u);
            else XB_SPIN(xb_ld(&bar[XB_TOPGEN]) == tg, bar);
            __builtin_amdgcn_fence(__ATOMIC_ACQUIRE, "agent");
            xb_add(&bar[XB_XGEN(b.x)], 1u);
            asm volatile("s_waitcnt vmcnt(0)" ::: "memory");
        } else {
            XB_SPIN(xb_ld(&bar[XB_XGEN(b.x)]) == gen, bar);
            __builtin_amdgcn_fence(__ATOMIC_ACQUIRE, "agent");
            asm volatile("s_waitcnt vmcnt(0)" ::: "memory");
        }
    }
    __syncthreads();
}

constexpr int XB_LDS_OFF = LDS_BYTES - 16;
constexpr size_t WS_BAR = 65536;

__global__ void __launch_bounds__(NWAVES * 64, 2) fwd_megakernel(Params p) {
    extern __shared__ __attribute__((aligned(16))) unsigned char lds_raw[];
    LAS unsigned char* lds = (LAS unsigned char*)lds_raw;
    cg::grid_group grid = cg::this_grid();
    if (threadIdx.x < 4) ((volatile LAS unsigned*)(lds + XB_LDS_OFF))[threadIdx.x] = 0u;
    __syncthreads();
    const XcdBarrier xbar = xcd_barrier_post((unsigned*)(p.ws + WS_BAR), (volatile LAS unsigned*)(lds + XB_LDS_OFF));
    int tid = threadIdx.x, lane = tid & 63, wave = __builtin_amdgcn_readfirstlane(tid >> 6);
#define RELAUNDER() do { tid = threadIdx.x; asm volatile("" : "+v"(tid)); lane = tid & 63; wave = __builtin_amdgcn_readfirstlane(tid >> 6); } while (0)
    unsigned char* ws = p.ws;
    bf16* XN = (bf16*)(ws + WS_XN); bf16* Zb = (bf16*)(ws + WS_Z); float* mod = (float*)(ws + WS_MOD);
    const int G = gridDim.x;

    RELAUNDER();
    for (int rep_ = 0; rep_ < REP_P0; ++rep_) { phase0(p, lds, tid, lane, wave); __syncthreads(); }
    xcd_barrier(xbar);
    RELAUNDER();
    for (int rep_ = 0; rep_ < REP_P1; ++rep_) norm_rows(p.in[0], p.in[5], mod, 0, 1024, XN, lane, wave);
    xcd_barrier(xbar);
    { pg8::Gemm g{XN, (const bf16*)(ws + WS_WIN), M, NIN, DM}; pg8::StaticOrder So; So.init(M, NIN, G, (int)blockIdx.x);
      pg8::EpiZ E{Zb, (float*)(ws + WS_G)};
      pg8::gemm_phase<pg8::EpiZ, pg8::StaticOrder, true, true>(lds, g, So, E); }
    xcd_barrier(xbar);
    RELAUNDER();
    for (int rep_ = 0; rep_ < REP_P3; ++rep_) { phase3(p, lds, tid, lane, wave, rep_ == 0); __syncthreads(); }
    xcd_barrier(xbar);
    RELAUNDER();
#ifndef SKIP_P4
    phase4(p, lds, tid, lane, wave);
#endif
    xcd_barrier(xbar);
    { pg8::Gemm g{(const bf16*)(ws + WS_ATTA), (const bf16*)(ws + WS_WUPA), M, DM, DM}; pg8::StaticOrder So; So.init(M, DM, G, (int)blockIdx.x);
      pg8::EpiUpF E{XN, Zb};
      pg8::gemm_phase<pg8::EpiUpF, pg8::StaticOrder, true, true>(lds, g, So, E); }
    xcd_barrier(xbar);
    { pg8::Gemm g{XN, (const bf16*)(ws + WS_WOUT), M, DM, DM}; pg8::StaticOrder So; So.init(M, DM, G, (int)blockIdx.x);
      pg8::EpiRes2 E{p.in[0], p.out, mod + 2048, p.in[6], mod + 4096, (bf16*)(ws + WS_ATTA), (float*)(ws + WS_ROWSS)};
      pg8::gemm_phase<pg8::EpiRes2, pg8::StaticOrder, true, true>(lds, g, So, E); }
    xcd_barrier(xbar);
    { pg8::Gemm g{(const bf16*)(ws + WS_ATTA), (const bf16*)(ws + WS_W1), M, FF, DM}; pg8::StaticOrder So; So.init(M, FF, G, (int)blockIdx.x);
      pg8::EpiRelu2N E{Zb, (const float*)(ws + WS_ROWSS), (const float*)(ws + WS_SW)};
      pg8::gemm_phase<pg8::EpiRelu2N, pg8::StaticOrder, true, true>(lds, g, So, E); }
    xcd_barrier(xbar);
    { pg8::Gemm g{Zb, (const bf16*)(ws + WS_W2), M, DM, FF}; pg8::StaticOrder So; So.init(M, DM, G, (int)blockIdx.x);
      pg8::EpiRes E{p.out, p.out, mod + 5120};
      pg8::gemm_phase<pg8::EpiRes, pg8::StaticOrder, true, true>(lds, g, So, E); }
    if (__hip_atomic_load((unsigned*)(p.ws + WS_BAR) + XB_TMO, __ATOMIC_RELAXED, __HIP_MEMORY_SCOPE_AGENT) == 0xDEADBEEFu) grid.sync();
}

extern "C" void kernel_launch(void* const* d_in, const int* in_sizes, int n_in, void* d_out, int out_size, void* d_ws, size_t ws_size, hipStream_t stream) {
    static int grid = 0;
    if (grid == 0) {
        if (n_in != 20 || ws_size < WS_END) { fprintf(stderr, "kernel_launch: unexpected inputs (n_in %d, ws %zu)\n", n_in, ws_size); grid = -1; return; }
        int dev = 0, cus = 0, per_cu = 0;
        hipGetDevice(&dev); hipDeviceGetAttribute(&cus, hipDeviceAttributeMultiprocessorCount, dev);
        if (hipFuncSetAttribute((const void*)fwd_megakernel, hipFuncAttributeMaxDynamicSharedMemorySize, LDS_BYTES) != hipSuccess) fprintf(stderr, "kernel_launch: hipFuncSetAttribute failed\n");
        if (hipOccupancyMaxActiveBlocksPerMultiprocessor(&per_cu, (const void*)fwd_megakernel, NWAVES * 64, LDS_BYTES) != hipSuccess || per_cu < 1) { fprintf(stderr, "kernel_launch: occupancy query gave %d\n", per_cu); per_cu = 1; }
        (void)hipGetLastError();
        grid = cus * per_cu;
    }
    if (grid < 0) return;
    if (hipMemsetAsync(d_ws, 0, 1 << 20, stream) != hipSuccess) { fprintf(stderr, "kernel_launch: hipMemsetAsync of the barrier words failed\n"); return; }
    Params p{};
    for (int i = 0; i < 20; ++i) p.in[i] = (const float*)d_in[i];
    p.out = (float*)d_out; p.ws = (unsigned char*)d_ws;
    void* args[] = {&p};
    hipError_t e = hipLaunchCooperativeKernel((const void*)fwd_megakernel, dim3(grid), dim3(NWAVES * 64), args, LDS_BYTES, stream);
    if (e != hipSuccess) fprintf(stderr, "kernel_launch: cooperative launch failed: %s (grid %d)\n", hipGetErrorString(e), grid);
}
```
